# Optimizing an MI355X kernel written in HIP

```python
import jax, jax.numpy as jnp
from jax import lax
import numpy as np

D_MODEL = 1024
BATCH = 4
SEQ = 4096
DEPTH = 2

ATT_HEADS = 4
D_ATT = D_MODEL // 2
ATT_DV = D_ATT // ATT_HEADS
ATT_DK = ATT_DV // 2
CC_CH = D_MODEL // 4
CC_GROUPS = 4
CC_K = 31
SC_CH = D_MODEL // 4
SC_K = 3
D_MIX = D_ATT + CC_CH + SC_CH
Q_COLS = ATT_HEADS * 2 * ATT_DK
K_COLS = ATT_HEADS * 2 * ATT_DK
V_COLS = ATT_HEADS * ATT_DV
CC_COLS = 2 * CC_CH
SC_COLS = 3 * SC_CH
D_IN = Q_COLS + K_COLS + V_COLS + CC_COLS + SC_COLS
D_FF = ((8 * D_MODEL // 3 + 255) // 256) * 256
MEM_LEN = 256
XA_HEADS = 4
XA_HD = D_MODEL // XA_HEADS
Q_BLOCK = 128
EPS = 1e-6

kernel_name = "hymba_style_diffattn_conformer_shortconv_hybrid"


def rms_norm(x, g):
    xf = x.astype(jnp.float32)
    y = xf * lax.rsqrt(jnp.mean(xf * xf, axis=-1, keepdims=True) + EPS)
    return (y * g.astype(jnp.float32)).astype(x.dtype)


def layer_norm(x, g, b):
    xf = x.astype(jnp.float32)
    mu = jnp.mean(xf, axis=-1, keepdims=True)
    var = jnp.mean(jnp.square(xf - mu), axis=-1, keepdims=True)
    y = (xf - mu) * lax.rsqrt(var + EPS)
    return (y * g.astype(jnp.float32) + b.astype(jnp.float32)).astype(x.dtype)


def swiglu(h, w_gate, w_up, w_down):
    return (jax.nn.silu(h @ w_gate) * (h @ w_up)) @ w_down


def causal_depthwise_conv(u, w):
    k_w, c = w.shape
    return lax.conv_general_dilated(
        u, w[:, None, :].astype(u.dtype), window_strides=(1,), padding=[(k_w - 1, 0)],
        dimension_numbers=("NWC", "WIO", "NWC"), feature_group_count=c)


def diff_attention(q, k, v, lam, slopes):
    b, t = q.shape[0], q.shape[1]
    n_blocks = t // Q_BLOCK
    kpos = jnp.arange(t)
    scale = ATT_DK ** -0.5

    def block(i):
        start = i * Q_BLOCK
        qb = lax.dynamic_slice_in_dim(q, start, Q_BLOCK, axis=1)
        s = jnp.einsum("bqhcd,bkhcd->bhcqk", qb, k).astype(jnp.float32) * scale
        dist = (start + jnp.arange(Q_BLOCK))[:, None] - kpos[None, :]
        bias = -slopes[:, None, None] * dist.astype(jnp.float32)[None]
        s = jnp.where((dist >= 0)[None, None, None], s + bias[None, :, None], -jnp.inf)
        p = jax.nn.softmax(s, axis=-1)
        a = p[:, :, 0] - lam * p[:, :, 1]
        return jnp.einsum("bhqk,bkhd->bqhd", a.astype(v.dtype), v)

    out = lax.map(block, jnp.arange(n_blocks))
    return jnp.moveaxis(out, 0, 1).reshape(b, t, ATT_HEADS, ATT_DV)


def setup_inputs(seed: int = 0) -> dict:
    key = jax.random.key(seed)
    ks = iter(jax.random.split(key, 40))

    def nrm(shape, scale):
        return jax.random.normal(next(ks), shape, jnp.float32) * scale

    def gain(shape):
        return 1.0 + nrm(shape, 0.02)

    L, D, F = DEPTH, D_MODEL, D_FF
    return {
        "x": nrm((BATCH, SEQ, D), 1.0),
        "mem": nrm((BATCH, MEM_LEN, D), 1.0),
        "ffn1_norm": gain((L, D)),
        "ffn1_w_gate": nrm((L, D, F), D ** -0.5),
        "ffn1_w_up": nrm((L, D, F), D ** -0.5),
        "ffn1_w_down": nrm((L, F, D), F ** -0.5),
        "mix_norm": gain((L, D)),
        "w_in": nrm((L, D, D_IN), D ** -0.5),
        "lam_q1": nrm((L, ATT_DK), 0.1),
        "lam_k1": nrm((L, ATT_DK), 0.1),
        "lam_q2": nrm((L, ATT_DK), 0.1),
        "lam_k2": nrm((L, ATT_DK), 0.1),
        "diff_subln": gain((L, ATT_DV)),
        "cc_dw": nrm((L, CC_K, CC_CH), CC_K ** -0.5),
        "cc_dw_b": nrm((L, CC_CH), 0.01),
        "cc_ln_g": gain((L, CC_CH)),
        "cc_ln_b": nrm((L, CC_CH), 0.01),
        "sc_dw": nrm((L, SC_K, SC_CH), SC_K ** -0.5),
        "w_out": nrm((L, D_MIX, D), D_MIX ** -0.5),
        "xa_norm": gain((L, D)),
        "mem_norm": gain((L, D)),
        "xa_wq": nrm((L, D, XA_HEADS * XA_HD), D ** -0.5),
        "xa_wkv": nrm((L, D, 2 * XA_HEADS * XA_HD), D ** -0.5),
        "xa_wo": nrm((L, XA_HEADS * XA_HD, D), D ** -0.5),
        "ffn2_norm": gain((L, D)),
        "ffn2_w_gate": nrm((L, D, F), D ** -0.5),
        "ffn2_w_up": nrm((L, D, F), D ** -0.5),
        "ffn2_w_down": nrm((L, F, D), F ** -0.5),
        "final_norm": gain((D,)),
    }


def reference(x, mem, ffn1_norm, ffn1_w_gate, ffn1_w_up, ffn1_w_down, mix_norm, w_in,
              lam_q1, lam_k1, lam_q2, lam_k2, diff_subln, cc_dw, cc_dw_b, cc_ln_g, cc_ln_b,
              sc_dw, w_out, xa_norm, mem_norm, xa_wq, xa_wkv, xa_wo, ffn2_norm, ffn2_w_gate,
              ffn2_w_up, ffn2_w_down, final_norm):
    b, t, _ = x.shape
    slopes = 2.0 ** (-8.0 * jnp.arange(1, ATT_HEADS + 1, dtype=jnp.float32) / ATT_HEADS)

    for l in range(DEPTH):
        x = x + 0.5 * swiglu(rms_norm(x, ffn1_norm[l]), ffn1_w_gate[l], ffn1_w_up[l], ffn1_w_down[l])

        z = rms_norm(x, mix_norm[l]) @ w_in[l]
        zq, zk, zv, zc, zs = jnp.split(
            z, np.cumsum([Q_COLS, K_COLS, V_COLS, CC_COLS])[:].tolist(), axis=-1)

        lam_init = 0.8 - 0.6 * float(np.exp(-0.3 * l))
        lam = (jnp.exp(jnp.sum(lam_q1[l].astype(jnp.float32) * lam_k1[l].astype(jnp.float32)))
               - jnp.exp(jnp.sum(lam_q2[l].astype(jnp.float32) * lam_k2[l].astype(jnp.float32)))
               + lam_init)
        q = zq.reshape(b, t, ATT_HEADS, 2, ATT_DK)
        k = zk.reshape(b, t, ATT_HEADS, 2, ATT_DK)
        v = zv.reshape(b, t, ATT_HEADS, ATT_DV)
        o_att = diff_attention(q, k, v, lam, slopes)
        o_att = (rms_norm(o_att, diff_subln[l]) * (1.0 - lam_init)).reshape(b, t, D_ATT)

        ca, cg = jnp.split(zc, 2, axis=-1)
        u = ca * jax.nn.sigmoid(cg)
        u = causal_depthwise_conv(u, cc_dw[l]) + cc_dw_b[l]
        o_cc = jax.nn.silu(layer_norm(u, cc_ln_g[l], cc_ln_b[l]))

        gb, gc, hs = jnp.split(zs, 3, axis=-1)
        o_sc = gb * causal_depthwise_conv(gc * hs, sc_dw[l])

        x = x + jnp.concatenate([o_att, o_cc, o_sc], axis=-1) @ w_out[l]

        hq = (rms_norm(x, xa_norm[l]) @ xa_wq[l]).reshape(b, t, XA_HEADS, XA_HD)
        kv = rms_norm(mem, mem_norm[l]) @ xa_wkv[l]
        mk, mv = jnp.split(kv.reshape(b, MEM_LEN, 2, XA_HEADS, XA_HD), 2, axis=2)
        mk, mv = mk[:, :, 0], mv[:, :, 0]
        s = jnp.einsum("bqhd,bmhd->bhqm", hq, mk).astype(jnp.float32) * (XA_HD ** -0.5)
        p = jax.nn.softmax(s, axis=-1).astype(mv.dtype)
        o = jnp.einsum("bhqm,bmhd->bqhd", p, mv).reshape(b, t, XA_HEADS * XA_HD)
        x = x + o @ xa_wo[l]

        x = x + 0.5 * swiglu(rms_norm(x, ffn2_norm[l]), ffn2_w_gate[l], ffn2_w_up[l], ffn2_w_down[l])

    return rms_norm(x, final_norm)
```

```cpp
#include <hip/hip_runtime.h>
#include <hip/hip_cooperative_groups.h>
#include <cstdio>
#include <cstdint>
namespace cg = cooperative_groups;
__device__ __forceinline__ int tid_opq() { int t = threadIdx.x; asm volatile("" : "+v"(t)); return t; }
__device__ __forceinline__ int bid_opq() { int b = blockIdx.x; asm volatile("" : "+s"(b)); return b; }
namespace pg8 {
#define PG8_LAS __attribute__((address_space(3)))
typedef unsigned short bf16_t;
typedef short bf16x8 __attribute__((ext_vector_type(8)));
typedef float f32x4 __attribute__((ext_vector_type(4)));
typedef unsigned u32x4 __attribute__((ext_vector_type(4)));
constexpr int BM = 256, BK = 64, HALF = 128, HTB = HALF * BK * 2  , STAGE_BYTES = 8 * HTB, NXCD = 8, WGM = 8;

__host__ __device__ __forceinline__ int lds_byte(int r, int c) { const int st = (r >> 4) * 2 + (c >> 5), rr = r & 15, cc = c & 31, ob = rr * 64 + cc * 2; return st * 1024 + (ob ^ (((ob >> 9) & 1) << 5)); }
__host__ __device__ __forceinline__ void stage_rc(int b, int& R, int& C) { const int st = b / 1024, sb = b % 1024, swz = sb ^ (((sb >> 9) & 1) << 5); R = (st >> 1) * 16 + swz / 64; C = (st & 1) * 32 + (swz % 64) / 2; }
__host__ __device__ __forceinline__ int perm32(int rho) { const int n = rho >> 4, i = rho & 15; return 8 * (i >> 2) + 4 * n + (i & 3); }

struct Unit { int pm, pn; };
struct Gemm { const bf16_t* A; const bf16_t* Bt; int M, N, K; };

struct StaticOrder {
    int nM, nN, nwg, G, c;
    __host__ __device__ void init(int M, int N, int G_, int c_) { nM = M / BM; nN = N / BM; nwg = nM * nN; G = G_; c = c_; }
    __host__ __device__ bool next(int i, Unit& u) const {
        const long L = (long)i * G + c; if (L >= nwg) return false;
        int wgid = (int)L; { const int q = nwg / NXCD, r = nwg % NXCD, xcd = wgid % NXCD, off = wgid / NXCD; wgid = (xcd < r ? xcd * (q + 1) : r * (q + 1) + (xcd - r) * q) + off; }
        const int nig = WGM * nN, gid = wgid / nig, fm = gid * WGM, gsz = (nM - fm) < WGM ? (nM - fm) : WGM;
        u.pm = fm + ((wgid % nig) % gsz); u.pn = (wgid % nig) / gsz; return true;
    }
    __device__ __forceinline__ void a_ready(const Unit&) const {}
    __device__ __forceinline__ void done(const Unit&) const {}
};
__device__ __forceinline__ unsigned cvt_pk_bf16(float lo, float hi) { unsigned r; asm volatile("v_cvt_pk_bf16_f32 %0, %1, %2" : "=v"(r) : "v"(lo), "v"(hi)); return r; }
template <class Epi, class Sched, bool ALIGN_EPI = false, bool SP2 = false>
__device__ __forceinline__ void gemm_phase(PG8_LAS unsigned char* lds, const Gemm g, const Sched S, const Epi E) {
    const int tid = tid_opq(), wid = __builtin_amdgcn_readfirstlane(tid >> 6), lane = tid & 63, wr = wid >> 2, wc = wid & 3, fr = lane & 15, fq = lane >> 4;
    const int K = g.K, nt = K / BK;
    unsigned voffA[2], voffB[2];
#pragma unroll
    for (int i = 0; i < 2; ++i) { int R, C; stage_rc(tid * 16 + i * 8192, R, C); const int Rb = Epi::PERM ? ((R & ~31) + perm32(R & 31)) : R;
        voffA[i] = (unsigned)(R * K + C) * 2u; voffB[i] = (unsigned)(Rb * K + C) * 2u; }
    const size_t kstep = (size_t)(BK * 2);
    const size_t hstep = (size_t)HALF * K * 2;
    const size_t tstep = 2 * hstep;
    const unsigned ldsw = (unsigned)wid * 1024u;
    const int aoff = lds_byte(wr * 64 + fr, fq * 8), boff = lds_byte(wc * 32 + fr, fq * 8);
#define PG8_SA(b, h) (((b) * 2 + (h)) * HTB)
#define PG8_SB(b, h) ((4 + (b) * 2 + (h)) * HTB)
#define PG8_STAGE(bufoff, gbase, voff) do { _Pragma("unroll") for (int _i = 0; _i < 2; ++_i) \
        __builtin_amdgcn_global_load_lds((const unsigned*)((const char*)(gbase) + (voff)[_i]), (PG8_LAS unsigned*)(lds + (bufoff) + ldsw + _i * 8192), 16, 0, 0); } while (0)
#define PG8_LDA(dst, b, h) do { _Pragma("unroll") for (int m = 0; m < 4; ++m) _Pragma("unroll") for (int k = 0; k < 2; ++k) dst[m][k] = *(const PG8_LAS bf16x8*)(lds + PG8_SA(b, h) + aoff + m * 2048 + k * 1024); } while (0)
#define PG8_LDB(dst, b, h) do { _Pragma("unroll") for (int n = 0; n < 2; ++n) _Pragma("unroll") for (int k = 0; k < 2; ++k) dst[n][k] = *(const PG8_LAS bf16x8*)(lds + PG8_SB(b, h) + boff + n * 2048 + k * 1024); } while (0)
#define PG8_MMA(ai, bj, At, Bt) do { __builtin_amdgcn_s_setprio(1); _Pragma("unroll") for (int m = 0; m < 4; ++m) _Pragma("unroll") for (int n = 0; n < 2; ++n) _Pragma("unroll") for (int k = 0; k < 2; ++k) \
        acc[ai][bj][m][n] = __builtin_amdgcn_mfma_f32_16x16x32_bf16(Bt[n][k], At[m][k], acc[ai][bj][m][n], 0, 0, 0); __builtin_amdgcn_s_setprio(0); } while (0)
#define PG8_WAIT_V(n) asm volatile("s_waitcnt vmcnt(" #n ")" ::: "memory")
#define PG8_WAIT_L(n) asm volatile("s_waitcnt lgkmcnt(" #n ")" ::: "memory")
#define PG8_BAR __builtin_amdgcn_s_barrier()
#define PG8_SCHED __builtin_amdgcn_sched_barrier(0)
    Unit cur, nxt; int ui = 0;
    if (!S.next(0, cur)) return;
    f32x4 acc[2][2][4][2];
    E.init_acc(acc, cur, wr, wc, fr, fq);
    bf16x8 At[4][2], B0[2][2], B1[2][2];
    const char* cA = (const char*)g.A + (size_t)cur.pm * tstep; const char* cB = (const char*)g.Bt + (size_t)cur.pn * tstep;
    S.a_ready(cur);
    float pre[8]; E.prefetch(cur, wr, fr, pre);
    if constexpr (SP2) {
        PG8_STAGE(PG8_SB(0, 0), cB, voffB); PG8_STAGE(PG8_SB(0, 1), cB + hstep, voffB); PG8_STAGE(PG8_SA(0, 0), cA, voffA); PG8_STAGE(PG8_SA(0, 1), cA + hstep, voffA);
        if (wr == 1) PG8_BAR;
        PG8_WAIT_V(2); PG8_BAR;
        PG8_STAGE(PG8_SB(1, 0), cB + kstep, voffB); PG8_STAGE(PG8_SA(1, 0), cA + kstep, voffA); PG8_STAGE(PG8_SB(1, 1), cB + hstep + kstep, voffB);
        PG8_WAIT_V(6); PG8_BAR;
    } else {
        PG8_STAGE(PG8_SB(0, 0), cB, voffB); PG8_STAGE(PG8_SA(0, 0), cA, voffA); PG8_STAGE(PG8_SB(0, 1), cB + hstep, voffB); PG8_STAGE(PG8_SA(0, 1), cA + hstep, voffA);
        if (wr == 1) PG8_BAR;
        PG8_WAIT_V(4); PG8_BAR;
        PG8_STAGE(PG8_SB(1, 0), cB + kstep, voffB); PG8_STAGE(PG8_SA(1, 0), cA + kstep, voffA); PG8_STAGE(PG8_SB(1, 1), cB + hstep + kstep, voffB);
        PG8_WAIT_V(6); PG8_BAR;
    }
    E.settle(acc);
    for (;;) {
        const bool has_next = S.next(ui + 1, nxt);
        const char* nA = has_next ? (const char*)g.A + (size_t)nxt.pm * tstep : cA; const char* nB = has_next ? (const char*)g.Bt + (size_t)nxt.pn * tstep : cB;
        for (int t = 0; t < nt; t += 2) {
            const bool last = (t == nt - 2);
            const char* a1 = cA + (size_t)(t + 1) * kstep;
            const char* a2 = last ? nA : cA + (size_t)(t + 2) * kstep; const char* b2 = last ? nB : cB + (size_t)(t + 2) * kstep;
            const char* a3 = a2 + kstep; const char* b3 = b2 + kstep;
            if (last && has_next) S.a_ready(nxt);
            if constexpr (SP2) {
            PG8_LDB(B0, 0, 0); PG8_LDB(B1, 0, 1); PG8_SCHED; PG8_LDA(At, 0, 0); PG8_STAGE(PG8_SA(1, 1), a1 + hstep, voffA);
            PG8_WAIT_V(8); PG8_WAIT_L(0); PG8_BAR; PG8_MMA(0, 0, At, B0); PG8_MMA(0, 1, At, B1); PG8_BAR; PG8_SCHED;
            PG8_LDA(At, 0, 1); PG8_STAGE(PG8_SB(0, 0), b2, voffB); PG8_STAGE(PG8_SB(0, 1), b2 + hstep, voffB); PG8_STAGE(PG8_SA(0, 0), a2, voffA);
            PG8_WAIT_V(8); PG8_WAIT_L(0); PG8_BAR; PG8_MMA(1, 0, At, B0); PG8_MMA(1, 1, At, B1); PG8_BAR; PG8_SCHED;
            PG8_LDB(B0, 1, 0); PG8_LDB(B1, 1, 1); PG8_SCHED; PG8_LDA(At, 1, 0); PG8_STAGE(PG8_SA(0, 1), a2 + hstep, voffA);
            PG8_WAIT_V(8); PG8_WAIT_L(0); PG8_BAR; PG8_MMA(0, 0, At, B0); PG8_MMA(0, 1, At, B1); PG8_BAR; PG8_SCHED;
            PG8_LDA(At, 1, 1); PG8_STAGE(PG8_SB(1, 0), b3, voffB); PG8_STAGE(PG8_SB(1, 1), b3 + hstep, voffB); PG8_STAGE(PG8_SA(1, 0), a3, voffA);
            PG8_WAIT_V(8); PG8_WAIT_L(0); PG8_BAR; PG8_MMA(1, 0, At, B0); PG8_MMA(1, 1, At, B1); PG8_BAR; PG8_SCHED;
            } else {
            PG8_LDB(B0, 0, 0); PG8_SCHED; PG8_LDA(At, 0, 0); PG8_STAGE(PG8_SA(1, 1), a1 + hstep, voffA);
            PG8_WAIT_L(8); PG8_BAR; PG8_WAIT_L(0); PG8_MMA(0, 0, At, B0); PG8_BAR; PG8_SCHED;
            PG8_LDB(B1, 0, 1); PG8_STAGE(PG8_SB(0, 0), b2, voffB);
            PG8_BAR; PG8_WAIT_L(0); PG8_MMA(0, 1, At, B1); PG8_BAR;
            PG8_LDA(At, 0, 1); PG8_STAGE(PG8_SA(0, 0), a2, voffA);
            PG8_BAR; PG8_WAIT_L(0); PG8_MMA(1, 0, At, B0); PG8_BAR; PG8_SCHED;
            PG8_STAGE(PG8_SB(0, 1), b2 + hstep, voffB);
            PG8_WAIT_V(6); PG8_BAR; PG8_MMA(1, 1, At, B1); PG8_BAR;
            PG8_LDB(B0, 1, 0); PG8_SCHED; PG8_LDA(At, 1, 0); PG8_STAGE(PG8_SA(0, 1), a2 + hstep, voffA);
            PG8_WAIT_L(8); PG8_BAR; PG8_WAIT_L(0); PG8_MMA(0, 0, At, B0); PG8_BAR; PG8_SCHED;
            PG8_LDB(B1, 1, 1); PG8_STAGE(PG8_SB(1, 0), b3, voffB);
            PG8_BAR; PG8_WAIT_L(0); PG8_MMA(0, 1, At, B1); PG8_BAR;
            PG8_LDA(At, 1, 1); PG8_STAGE(PG8_SA(1, 0), a3, voffA);
            PG8_BAR; PG8_WAIT_L(0); PG8_MMA(1, 0, At, B0); PG8_BAR; PG8_SCHED;
            PG8_STAGE(PG8_SB(1, 1), b3 + hstep, voffB);
            PG8_WAIT_V(6); PG8_BAR; PG8_MMA(1, 1, At, B1); PG8_BAR;
            }
        }
        if constexpr (ALIGN_EPI) { if (wr == 0) PG8_BAR; }
        if constexpr (!Epi::AFTER_DRAIN) { E(acc, cur, wr, wc, fr, fq, pre); S.done(cur); }
        if (!has_next) break;
        cur = nxt; cA = nA; cB = nB; ++ui; E.prefetch(cur, wr, fr, pre); E.init_acc(acc, cur, wr, wc, fr, fq); E.settle(acc);
        if constexpr (ALIGN_EPI) { if (wr == 1) PG8_BAR; }
    }
    PG8_WAIT_V(0);
    if constexpr (!ALIGN_EPI) { if (wr == 0) PG8_BAR; }
    PG8_BAR;
    if constexpr (Epi::AFTER_DRAIN) { E.fused(acc, cur, wr, wc, fr, fq, lds, wid, lane); S.done(cur); }
#undef PG8_SA
#undef PG8_SB
#undef PG8_STAGE
#undef PG8_LDA
#undef PG8_LDB
#undef PG8_MMA
#undef PG8_WAIT_V
#undef PG8_WAIT_L
#undef PG8_BAR
#undef PG8_SCHED
}
}
using pg8::bf16_t; using pg8::bf16x8; using pg8::f32x4; using pg8::u32x4; using pg8::Unit;
#define LAS __attribute__((address_space(3)))
typedef float f32x16 __attribute__((ext_vector_type(16)));
typedef float f32x2_t __attribute__((ext_vector_type(2)));
typedef __bf16 bf16x2_t __attribute__((ext_vector_type(2)));
typedef short s16x4 __attribute__((ext_vector_type(4)));
typedef short v4i16_t __attribute__((ext_vector_type(4)));
typedef unsigned u32x2 __attribute__((ext_vector_type(2)));

constexpr int DM = 1024, NB = 4, SEQ = 4096, MTOK = NB * SEQ, DEPTH = 2, DFF = 2816, DIN = 2816, MEML = 256, MMEM = NB * MEML;
constexpr float LOG2E = 1.4426950408889634f;
constexpr int LDS_BYTES = 147456;

__device__ __forceinline__ unsigned cvtpk(float lo, float hi) { f32x2_t v = {lo, hi}; bf16x2_t b = __builtin_convertvector(v, bf16x2_t); return __builtin_bit_cast(unsigned, b); }
__device__ __forceinline__ float bflo(unsigned u) { return __builtin_bit_cast(float, u << 16); }
__device__ __forceinline__ float bfhi(unsigned u) { return __builtin_bit_cast(float, u & 0xffff0000u); }
__device__ __forceinline__ float wave_sum(float v) { v += __shfl_xor(v, 32); v += __shfl_xor(v, 16); v += __shfl_xor(v, 8); v += __shfl_xor(v, 4); v += __shfl_xor(v, 2); v += __shfl_xor(v, 1); return v; }
__device__ __forceinline__ float silu_f(float g) { return g * __builtin_amdgcn_rcpf(1.f + __builtin_amdgcn_exp2f(g * -1.4426950408889634f)); }

struct OffOrder {
    int nM, nN, nwg, G, c;
    __device__ void init(int M, int N, int G_, int c_, int off) { nM = M / 256; nN = N / 256; nwg = nM * nN; G = G_; c = c_ - off; if (c < 0) c += G_; }
    __device__ bool next(int i, Unit& u) const {
        const long L = (long)i * G + c; if (L >= nwg) return false;
        int wgid = (int)L; { const int q = nwg / 8, r = nwg % 8, xcd = wgid % 8, off = wgid / 8; wgid = (xcd < r ? xcd * (q + 1) : r * (q + 1) + (xcd - r) * q) + off; }
        const int nig = 8 * nN, gid = wgid / nig, fm = gid * 8, gsz = (nM - fm) < 8 ? (nM - fm) : 8;
        u.pm = fm + ((wgid % nig) % gsz); u.pn = (wgid % nig) / gsz; return true;
    }
    __device__ __forceinline__ void a_ready(const Unit&) const {}
    __device__ __forceinline__ void done(const Unit&) const {}
};

struct EpiStore {
    static constexpr bool PERM = true, AFTER_DRAIN = false;
    bf16_t* O; const float* RS; int ldc; int pad_;
    __device__ __forceinline__ void prefetch(const Unit& u, int wr, int fr, float (&pre)[8]) const {
        const int row0 = u.pm * 256 + wr * 64 + fr;
#pragma unroll
        for (int i = 0; i < 8; ++i) pre[i] = RS ? RS[row0 + (i >> 2) * 128 + (i & 3) * 16] : 0.f;
    }
    __device__ __forceinline__ void init_acc(f32x4 (&acc)[2][2][4][2], const Unit&, int, int, int, int) const {
#pragma unroll
        for (int a = 0; a < 2; ++a)
#pragma unroll
            for (int b = 0; b < 2; ++b)
#pragma unroll
                for (int m = 0; m < 4; ++m)
#pragma unroll
                    for (int n = 0; n < 2; ++n) acc[a][b][m][n] = (f32x4){0.f, 0.f, 0.f, 0.f};
    }
    __device__ __forceinline__ void settle(f32x4 (&)[2][2][4][2]) const {}
    __device__ __forceinline__ void operator()(const f32x4 (&acc)[2][2][4][2], const Unit& u, int wr, int wc, int fr, int fq, const float (&pre)[8]) const {
        const int row0 = u.pm * 256 + wr * 64 + fr, col0 = u.pn * 256 + wc * 32 + 8 * fq;
#pragma unroll
        for (int ai = 0; ai < 2; ++ai)
#pragma unroll
            for (int m = 0; m < 4; ++m) { bf16_t* rowp = O + (size_t)(row0 + ai * 128 + m * 16) * ldc + col0; const float r = RS ? rsqrtf(pre[ai * 4 + m] * (1.f / 1024.f) + 1e-6f) : 1.f;
#pragma unroll
                for (int bj = 0; bj < 2; ++bj) { const f32x4 v0 = acc[ai][bj][m][0] * r, v1 = acc[ai][bj][m][1] * r; u32x4 w; w.x = cvtpk(v0[0], v0[1]); w.y = cvtpk(v0[2], v0[3]); w.z = cvtpk(v1[0], v1[1]); w.w = cvtpk(v1[2], v1[3]);
                    *(u32x4*)(rowp + bj * 128) = w; } }
    }
};
struct EpiSwiglu {
    static constexpr bool PERM = true, AFTER_DRAIN = false;
    bf16_t* O; const float* RS; int ldc; int pad_;
    __device__ __forceinline__ void prefetch(const Unit& u, int wr, int fr, float (&pre)[8]) const {
        const int row0 = u.pm * 256 + wr * 64 + fr;
#pragma unroll
        for (int i = 0; i < 8; ++i) pre[i] = RS[row0 + (i >> 2) * 128 + (i & 3) * 16];
    }
    __device__ __forceinline__ void init_acc(f32x4 (&acc)[2][2][4][2], const Unit&, int, int, int, int) const {
#pragma unroll
        for (int a = 0; a < 2; ++a)
#pragma unroll
            for (int b = 0; b < 2; ++b)
#pragma unroll
                for (int m = 0; m < 4; ++m)
#pragma unroll
                    for (int n = 0; n < 2; ++n) acc[a][b][m][n] = (f32x4){0.f, 0.f, 0.f, 0.f};
    }
    __device__ __forceinline__ void settle(f32x4 (&)[2][2][4][2]) const {}
    __device__ __forceinline__ void operator()(const f32x4 (&acc)[2][2][4][2], const Unit& u, int wr, int wc, int fr, int fq, const float (&pre)[8]) const {
        const int row0 = u.pm * 256 + wr * 64 + fr, col0 = u.pn * 128 + wc * 32 + 8 * fq;
#pragma unroll
        for (int ai = 0; ai < 2; ++ai)
#pragma unroll
            for (int m = 0; m < 4; ++m) { bf16_t* rowp = O + (size_t)(row0 + ai * 128 + m * 16) * ldc + col0; const float r = rsqrtf(pre[ai * 4 + m] * (1.f / 1024.f) + 1e-6f);
                const float k1 = r * -1.4426950408889634f, rr = r * r; u32x4 w;
#pragma unroll
                for (int n = 0; n < 2; ++n) { const f32x4 g = acc[ai][0][m][n], uu = acc[ai][1][m][n]; const f32x4 t = g * uu, x = g * k1; f32x4 d;
                    d[0] = __builtin_amdgcn_exp2f(x[0]); d[1] = __builtin_amdgcn_exp2f(x[1]); d[2] = __builtin_amdgcn_exp2f(x[2]); d[3] = __builtin_amdgcn_exp2f(x[3]);
                    d = d + 1.0f;
                    d[0] = __builtin_amdgcn_rcpf(d[0]); d[1] = __builtin_amdgcn_rcpf(d[1]); d[2] = __builtin_amdgcn_rcpf(d[2]); d[3] = __builtin_amdgcn_rcpf(d[3]);
                    const f32x4 o = (t * d) * rr;
                    if (n == 0) { w.x = cvtpk(o[0], o[1]); w.y = cvtpk(o[2], o[3]); } else { w.z = cvtpk(o[0], o[1]); w.w = cvtpk(o[2], o[3]); } }
                *(u32x4*)rowp = w; }
    }
};
struct HiLoIn {
    const float* Xin32; const bf16_t* HiIn; const bf16_t* LoIn;
    __device__ __forceinline__ void init(f32x4 (&acc)[2][2][4][2], const Unit& u, int wr, int wc, int fr, int fq) const {
        const int row0 = u.pm * 256 + wr * 64 + fr, col0 = u.pn * 256 + wc * 32 + 8 * fq;
#pragma unroll
        for (int ai = 0; ai < 2; ++ai)
#pragma unroll
            for (int m = 0; m < 4; ++m)
#pragma unroll
                for (int bj = 0; bj < 2; ++bj) { const size_t p = (size_t)(row0 + ai * 128 + m * 16) * DM + col0 + bj * 128;
                    if (Xin32) { acc[ai][bj][m][0] = *(const f32x4*)(Xin32 + p); acc[ai][bj][m][1] = *(const f32x4*)(Xin32 + p + 4); }
                    else { acc[ai][bj][m][0] = __builtin_bit_cast(f32x4, *(const u32x4*)(HiIn + p)); acc[ai][bj][m][1] = __builtin_bit_cast(f32x4, *(const u32x4*)(LoIn + p)); } }
    }
    __device__ __forceinline__ void settle(f32x4 (&acc)[2][2][4][2]) const {
#pragma unroll
        for (int a = 0; a < 2; ++a)
#pragma unroll
            for (int b = 0; b < 2; ++b)
#pragma unroll
                for (int m = 0; m < 4; ++m) {
                    asm volatile("" : "+v"(acc[a][b][m][0])); asm volatile("" : "+v"(acc[a][b][m][1]));
                    if (!Xin32) { const u32x4 h = __builtin_bit_cast(u32x4, acc[a][b][m][0]), l = __builtin_bit_cast(u32x4, acc[a][b][m][1]);
                        acc[a][b][m][0] = (f32x4){bflo(h.x) + bflo(l.x), bfhi(h.x) + bfhi(l.x), bflo(h.y) + bflo(l.y), bfhi(h.y) + bfhi(l.y)};
                        acc[a][b][m][1] = (f32x4){bflo(h.z) + bflo(l.z), bfhi(h.z) + bfhi(l.z), bflo(h.w) + bflo(l.w), bfhi(h.w) + bfhi(l.w)}; } }
    }
};
struct EpiResid {
    static constexpr bool PERM = true, AFTER_DRAIN = false;
    HiLoIn in; bf16_t* HiOut; bf16_t* LoOut; float* RS;
    __device__ __forceinline__ void prefetch(const Unit&, int, int, float (&)[8]) const {}
    __device__ __forceinline__ void init_acc(f32x4 (&acc)[2][2][4][2], const Unit& u, int wr, int wc, int fr, int fq) const { in.init(acc, u, wr, wc, fr, fq); }
    __device__ __forceinline__ void settle(f32x4 (&acc)[2][2][4][2]) const { in.settle(acc); }
    __device__ __forceinline__ void operator()(const f32x4 (&acc)[2][2][4][2], const Unit& u, int wr, int wc, int fr, int fq, const float (&)[8]) const {
        const int row0 = u.pm * 256 + wr * 64 + fr, col0 = u.pn * 256 + wc * 32 + 8 * fq;
        float ssv[2][4];
#pragma unroll
        for (int ai = 0; ai < 2; ++ai)
#pragma unroll
            for (int m = 0; m < 4; ++m) { const int row = row0 + ai * 128 + m * 16; float ss = 0.f;
#pragma unroll
                for (int bj = 0; bj < 2; ++bj) { const size_t p = (size_t)row * DM + col0 + bj * 128; const f32x4 a = acc[ai][bj][m][0], b = acc[ai][bj][m][1];
                    u32x4 w; w.x = cvtpk(a[0], a[1]); w.y = cvtpk(a[2], a[3]); w.z = cvtpk(b[0], b[1]); w.w = cvtpk(b[2], b[3]); *(u32x4*)(HiOut + p) = w;
                    u32x4 v; v.x = cvtpk(a[0] - bflo(w.x), a[1] - bfhi(w.x)); v.y = cvtpk(a[2] - bflo(w.y), a[3] - bfhi(w.y)); v.z = cvtpk(b[0] - bflo(w.z), b[1] - bfhi(w.z)); v.w = cvtpk(b[2] - bflo(w.w), b[3] - bfhi(w.w));
                    *(u32x4*)(LoOut + p) = v;
                    ss += (a[0] * a[0] + a[1] * a[1]) + (a[2] * a[2] + a[3] * a[3]) + (b[0] * b[0] + b[1] * b[1]) + (b[2] * b[2] + b[3] * b[3]); }
                ss += __shfl_xor(ss, 16); ss += __shfl_xor(ss, 32); ssv[ai][m] = ss; }
#pragma unroll
        for (int ai = 0; ai < 2; ++ai) { const float v = fq == 0 ? ssv[ai][0] : fq == 1 ? ssv[ai][1] : fq == 2 ? ssv[ai][2] : ssv[ai][3];
            (void)__hip_atomic_fetch_add(RS + row0 + ai * 128 + fq * 16, v, __ATOMIC_RELAXED, __HIP_MEMORY_SCOPE_AGENT); }
    }
};
struct EpiFinal {
    static constexpr bool PERM = true, AFTER_DRAIN = false;
    HiLoIn in; float* Out; float* RS; const float* g; unsigned* cnt;
    __device__ __forceinline__ void prefetch(const Unit&, int, int, float (&)[8]) const {}
    __device__ __forceinline__ void init_acc(f32x4 (&acc)[2][2][4][2], const Unit& u, int wr, int wc, int fr, int fq) const { in.init(acc, u, wr, wc, fr, fq); }
    __device__ __forceinline__ void settle(f32x4 (&acc)[2][2][4][2]) const { in.settle(acc); }
    __device__ __forceinline__ void operator()(const f32x4 (&acc_)[2][2][4][2], const Unit& u, int wr, int wc, int fr, int fq, const float (&)[8]) const {
        f32x4 (&acc)[2][2][4][2] = const_cast<f32x4 (&)[2][2][4][2]>(acc_);
        const int row0 = u.pm * 256 + wr * 64 + fr, col0 = u.pn * 256 + wc * 32 + 8 * fq;
        float ssv[2][4];
#pragma unroll
        for (int ai = 0; ai < 2; ++ai)
#pragma unroll
            for (int m = 0; m < 4; ++m) { const int row = row0 + ai * 128 + m * 16; const size_t ro = (size_t)row * DM + col0; float ss = 0.f;
#pragma unroll
                for (int bj = 0; bj < 2; ++bj) { const size_t p = ro + bj * 128;
                    const f32x4 a = acc[ai][bj][m][0], b = acc[ai][bj][m][1];
                    ss += (a[0] * a[0] + a[1] * a[1]) + (a[2] * a[2] + a[3] * a[3]) + (b[0] * b[0] + b[1] * b[1]) + (b[2] * b[2] + b[3] * b[3]); }
                ss += __shfl_xor(ss, 16); ss += __shfl_xor(ss, 32); ssv[ai][m] = ss; }
#pragma unroll
        for (int ai = 0; ai < 2; ++ai) { const float v = fq == 0 ? ssv[ai][0] : fq == 1 ? ssv[ai][1] : fq == 2 ? ssv[ai][2] : ssv[ai][3];
            (void)__hip_atomic_fetch_add(RS + row0 + ai * 128 + fq * 16, v, __ATOMIC_RELAXED, __HIP_MEMORY_SCOPE_AGENT); }
        asm volatile("s_waitcnt vmcnt(0)" ::: "memory");
        __syncthreads();
        if (tid_opq() == 0) {
            (void)__hip_atomic_fetch_add(cnt + u.pm * 16, 1u, __ATOMIC_RELEASE, __HIP_MEMORY_SCOPE_AGENT);
            unsigned spins = 0;
            while (__hip_atomic_load(cnt + u.pm * 16, __ATOMIC_ACQUIRE, __HIP_MEMORY_SCOPE_AGENT) < 4u && ++spins < (1u << 22)) __builtin_amdgcn_s_sleep(1);
        }
        __syncthreads();
        f32x4 gv[2][2];
#pragma unroll
        for (int bj = 0; bj < 2; ++bj) { gv[bj][0] = *(const f32x4*)(g + col0 + bj * 128); gv[bj][1] = *(const f32x4*)(g + col0 + bj * 128 + 4); }
#pragma unroll
        for (int ai = 0; ai < 2; ++ai)
#pragma unroll
            for (int m = 0; m < 4; ++m) { const int row = row0 + ai * 128 + m * 16; const size_t ro = (size_t)row * DM + col0;
                const float r = rsqrtf(__hip_atomic_load(RS + row, __ATOMIC_RELAXED, __HIP_MEMORY_SCOPE_AGENT) * (1.f / 1024.f) + 1e-6f);
#pragma unroll
                for (int bj = 0; bj < 2; ++bj) { const size_t p = ro + bj * 128;
                    *(f32x4*)(Out + p) = acc[ai][bj][m][0] * r * gv[bj][0]; *(f32x4*)(Out + p + 4) = acc[ai][bj][m][1] * r * gv[bj][1]; } }
    }
};

template <class Epi>
__device__ __forceinline__ void run_gemm(LAS unsigned char* lds, const bf16_t* A, const bf16_t* Bt, int M, int N, int K, const Epi E, int off = 0) {
    pg8::Gemm g; g.A = A; g.Bt = Bt; g.M = M; g.N = N; g.K = K;
    OffOrder S; S.init(M, N, (int)gridDim.x, bid_opq(), off);
    pg8::gemm_phase<Epi, OffOrder, true, true>(lds, g, S, E);
}

__device__ void cvt_w(LAS unsigned char* lds, const float* __restrict__ W, int K, int N, bf16_t* __restrict__ Bt, int mode, const float* __restrict__ gain = nullptr, int first = 0, int nblk = 0, float mul = 1.f) {
    LAS float* tile = (LAS float*)lds;
    const int tid = tid_opq(), ntn = N / 128, nt = (K / 64) * ntn;
    const int lk = tid >> 5, ln4 = (tid & 31) * 4;
    f32x4 v[4];
    const int tstride = nblk ? nblk : (int)gridDim.x;
    int t = bid_opq() - first;
    if (t < nt) { const int k0 = (t / ntn) * 64, n0 = (t % ntn) * 128;
#pragma unroll
        for (int i = 0; i < 4; ++i) v[i] = *(const f32x4*)(W + (size_t)(k0 + lk + 16 * i) * N + n0 + ln4); }
    for (; t < nt; t += tstride) {
        const int k0 = (t / ntn) * 64, n0 = (t % ntn) * 128;
        __syncthreads();
#pragma unroll
        for (int i = 0; i < 4; ++i) { const int kk = lk + 16 * i; f32x4 x = v[i] * mul; if (gain) x *= gain[k0 + kk];
            tile[kk * 129 + ln4] = x[0]; tile[kk * 129 + ln4 + 1] = x[1]; tile[kk * 129 + ln4 + 2] = x[2]; tile[kk * 129 + ln4 + 3] = x[3]; }
        const int tn = t + tstride;
        if (tn < nt) { const int k1 = (tn / ntn) * 64, n1 = (tn % ntn) * 128;
#pragma unroll
            for (int i = 0; i < 4; ++i) v[i] = *(const f32x4*)(W + (size_t)(k1 + lk + 16 * i) * N + n1 + ln4); }
        __syncthreads();
#pragma unroll
        for (int h = 0; h < 2; ++h) {
            const int n = (tid >> 3) + 64 * h, k8 = (tid & 7) * 8; float f[8];
#pragma unroll
            for (int j = 0; j < 8; ++j) f[j] = tile[(k8 + j) * 129 + n];
            const int nn = n0 + n; int row = nn; if (mode) row = (nn >> 7) * 256 + (nn & 127) + (mode == 2 ? 128 : 0);
            u32x4 w; w.x = cvtpk(f[0], f[1]); w.y = cvtpk(f[2], f[3]); w.z = cvtpk(f[4], f[5]); w.w = cvtpk(f[6], f[7]);
            *(u32x4*)(Bt + (size_t)row * K + k0 + k8) = w;
        }
    }
}

__device__ void norm_rows_bf16(const float* __restrict__ X, const float* __restrict__ g, bf16_t* __restrict__ H, int rows) {
    const int lane = tid_opq() & 63, gw = bid_opq() * 8 + (tid_opq() >> 6), stride = gridDim.x * 8;
    for (int r = gw; r < rows; r += stride) {
        const f32x4* xr = (const f32x4*)(X + (size_t)r * DM); f32x4 v[4]; float ss = 0.f;
#pragma unroll
        for (int i = 0; i < 4; ++i) { v[i] = xr[lane + 64 * i]; ss += v[i][0] * v[i][0] + v[i][1] * v[i][1] + v[i][2] * v[i][2] + v[i][3] * v[i][3]; }
        ss = wave_sum(ss); const float rstd = rsqrtf(ss * (1.f / DM) + 1e-6f);
#pragma unroll
        for (int i = 0; i < 4; ++i) { const f32x4 gg = ((const f32x4*)g)[lane + 64 * i]; u32x2 w; w.x = cvtpk(v[i][0] * rstd * gg[0], v[i][1] * rstd * gg[1]); w.y = cvtpk(v[i][2] * rstd * gg[2], v[i][3] * rstd * gg[3]);
            *(u32x2*)(H + (size_t)r * DM + (lane + 64 * i) * 4) = w; }
    }
}
__device__ void prep_rows(const float* __restrict__ X, bf16_t* __restrict__ XB, float* __restrict__ PS, int rows) {
    const int lane = tid_opq() & 63, gw = bid_opq() * 8 + (tid_opq() >> 6), stride = gridDim.x * 8;
    for (int r = gw; r < rows; r += stride) {
        const f32x4* xr = (const f32x4*)(X + (size_t)r * DM); float ss = 0.f;
#pragma unroll
        for (int i = 0; i < 4; ++i) { const f32x4 v = xr[lane + 64 * i]; ss += v[0] * v[0] + v[1] * v[1] + v[2] * v[2] + v[3] * v[3];
            u32x2 w; w.x = cvtpk(v[0], v[1]); w.y = cvtpk(v[2], v[3]); *(u32x2*)(XB + (size_t)r * DM + (lane + 64 * i) * 4) = w; }
        ss = wave_sum(ss);
        if (lane == 0) PS[r] = ss;
    }
}
__device__ void final_rows(const bf16_t* __restrict__ Hi, const bf16_t* __restrict__ Lo, float* __restrict__ Out, const float* __restrict__ PS, const float* __restrict__ g, int rows) {
    const int lane = tid_opq() & 63, gw = bid_opq() * 8 + (tid_opq() >> 6), stride = gridDim.x * 8;
    for (int r = gw; r < rows; r += stride) {
        const float rstd = rsqrtf(PS[r] * (1.f / DM) + 1e-6f);
#pragma unroll
        for (int i = 0; i < 2; ++i) { const size_t p = (size_t)r * DM + (lane + 64 * i) * 8; const u32x4 h = *(const u32x4*)(Hi + p), l = *(const u32x4*)(Lo + p);
            const f32x4 g0 = *(const f32x4*)(g + (lane + 64 * i) * 8), g1 = *(const f32x4*)(g + (lane + 64 * i) * 8 + 4);
            *(f32x4*)(Out + p) = (f32x4){bflo(h.x) + bflo(l.x), bfhi(h.x) + bfhi(l.x), bflo(h.y) + bflo(l.y), bfhi(h.y) + bfhi(l.y)} * rstd * g0;
            *(f32x4*)(Out + p + 4) = (f32x4){bflo(h.z) + bflo(l.z), bfhi(h.z) + bfhi(l.z), bflo(h.w) + bflo(l.w), bfhi(h.w) + bfhi(l.w)} * rstd * g1; }
    }
}
__device__ void norm_rows_f32(const float* X, const float* __restrict__ g, float* O, int rows) {
    const int lane = tid_opq() & 63, gw = bid_opq() * 8 + (tid_opq() >> 6), stride = gridDim.x * 8;
    for (int r = gw; r < rows; r += stride) {
        const f32x4* xr = (const f32x4*)(X + (size_t)r * DM); f32x4 v[4]; float ss = 0.f;
#pragma unroll
        for (int i = 0; i < 4; ++i) { v[i] = xr[lane + 64 * i]; ss += v[i][0] * v[i][0] + v[i][1] * v[i][1] + v[i][2] * v[i][2] + v[i][3] * v[i][3]; }
        ss = wave_sum(ss); const float rstd = rsqrtf(ss * (1.f / DM) + 1e-6f);
#pragma unroll
        for (int i = 0; i < 4; ++i) { const f32x4 gg = ((const f32x4*)g)[lane + 64 * i]; ((f32x4*)(O + (size_t)r * DM))[lane + 64 * i] = v[i] * rstd * gg; }
    }
}

__device__ __forceinline__ s16x4 vtr(LAS const unsigned char* p) { return __builtin_bit_cast(s16x4, __builtin_amdgcn_ds_read_tr16_b64_v4i16((LAS v4i16_t*)p)); }

template <bool DIFF>
__device__ __forceinline__ void attn_unit(LAS unsigned char* lds, const bf16_t* __restrict__ Qp, int qpitch, const bf16_t* __restrict__ Kp, const bf16_t* __restrict__ Vp, int kvpitch,
                                          int nkt, int qpos0, float sc2, float sl2, float lam, bf16_t* __restrict__ Op, int opitch, const float* __restrict__ subg, float oscale) {
    constexpr int ROWB = DIFF ? 256 : 512, CPR = ROWB / 16, KSTR = ROWB + 16, VSTR = ROWB + 64, KBY = 64 * KSTR, VBY = 64 * VSTR, STAGE = KBY + VBY, NCH = CPR / 8, NKS = DIFF ? 4 : 16;
    const int tid = tid_opq(), wid = __builtin_amdgcn_readfirstlane(tid >> 6), lane = tid & 63, c = wid >> 2, qr = (wid & 3) * 32, l32 = lane & 31, hi = lane >> 5;
    constexpr int QSTR = 528, QOFF = STAGE;
    bf16x8 qf[DIFF ? NKS : 1];
    if (DIFF) { const bf16_t* qrow = Qp + (size_t)(qr + l32) * qpitch + c * 64 + hi * 8;
#pragma unroll
      for (int ks = 0; ks < (DIFF ? NKS : 1); ++ks) qf[ks] = *(const bf16x8*)(qrow + ks * 16); }
    f32x16 o[4];
#pragma unroll
    for (int i = 0; i < 4; ++i)
#pragma unroll
        for (int r = 0; r < 16; ++r) o[i][r] = 0.f;
    float m_run = -INFINITY, l_run = 0.f;
    u32x4 kreg[NCH], vreg[NCH];
    const int srow = tid / CPR, sch = tid % CPR;
    const size_t goff = (size_t)srow * kvpitch + sch * 8;
    const int loffk = srow * KSTR + sch * 16, loffv = KBY + srow * VSTR + sch * 16;
#define ATT_GLOAD(kt) do { _Pragma("unroll") for (int i = 0; i < NCH; ++i) { const size_t go = goff + (size_t)((kt) * 64 + i * (512 / CPR)) * kvpitch; \
        kreg[i] = *(const u32x4*)(Kp + go); vreg[i] = *(const u32x4*)(Vp + go); } } while (0)
#define ATT_LSTORE(buf) do { LAS unsigned char* bb = lds + (buf) * STAGE; _Pragma("unroll") for (int i = 0; i < NCH; ++i) { \
        *(LAS u32x4*)(bb + loffk + i * (512 / CPR) * KSTR) = kreg[i]; *(LAS u32x4*)(bb + loffv + i * (512 / CPR) * VSTR) = vreg[i]; } } while (0)
    constexpr int DSTG = 32768;
    const int dch = (lane & 15) ^ ((((lane >> 4) & 3) << 2) | (wid & 3));
#define ATT_DMA(kt, st) do { _Pragma("unroll") for (int i = 0; i < 2; ++i) { const int j = wid + 8 * i; \
        const size_t go = (size_t)((kt) * 64 + j * 4 + (lane >> 4)) * kvpitch + dch * 8; \
        __builtin_amdgcn_global_load_lds((const unsigned*)(Kp + go), (LAS unsigned*)(lds + (st) * DSTG + j * 1024), 16, 0, 0); \
        __builtin_amdgcn_global_load_lds((const unsigned*)(Vp + go), (LAS unsigned*)(lds + (st) * DSTG + 16384 + j * 1024), 16, 0, 0); } } while (0)
    __syncthreads();
    if (DIFF) { ATT_DMA(nkt - 1, 0); }
    else { ATT_GLOAD(0);
#pragma unroll
        for (int i = 0; i < 8; ++i) { const int id = tid + 512 * i, row = id >> 5, ch = id & 31;
            *(LAS u32x4*)(lds + QOFF + row * QSTR + ch * 16) = *(const u32x4*)(Qp + (size_t)row * qpitch + ch * 8); }
    }
    const int wrow = qpos0 + qr;
    f32x16 biasv;
    { const float beta = DIFF ? sl2 / sc2 : 0.f;
#pragma unroll
      for (int r = 0; r < 16; ++r) biasv[r] = beta * (float)((r >> 2) * 8 + (r & 3) + hi * 4 - l32); }
    int it = 0;
#pragma unroll 1
    for (int kt = DIFF ? nkt - 1 : 0; DIFF ? (kt >= 0) : (kt < nkt); kt += DIFF ? -1 : 1, ++it) {
        if (DIFF) asm volatile("s_waitcnt vmcnt(0)" ::: "memory");
        __syncthreads();
        if (DIFF) { if (kt > 0) ATT_DMA(kt - 1, (it + 1) & 1); }
        else { ATT_LSTORE(0); if (kt + 1 < nkt) ATT_GLOAD(kt + 1); __syncthreads(); }
        const bool active = DIFF ? (64 * kt <= wrow) : true;
        if (active) {
            LAS const unsigned char* kb = DIFF ? lds + (it & 1) * DSTG : lds; LAS const unsigned char* vb = DIFF ? kb + 16384 : kb + KBY;
            LAS const unsigned char* qa = lds + QOFF + (qr + l32) * QSTR + hi * 16;
            f32x16 s0 = biasv, s1 = biasv;
            LAS const unsigned char* ka = kb + l32 * KSTR + (DIFF ? c * 128 : 0) + hi * 16;
#pragma unroll 1
            for (int kq = 0; kq < NKS; kq += 4) {
                bf16x8 ka0[4], ka1[4], qq[4];
#pragma unroll
                for (int j = 0; j < 4; ++j) {
                    if (DIFF) { const int ko = 256 * l32 + 16 * (((c << 3) + 2 * j + hi) ^ (((l32 & 3) << 2) | ((l32 >> 2) & 3)));
                        ka0[j] = *(LAS const bf16x8*)(kb + ko); ka1[j] = *(LAS const bf16x8*)(kb + 8192 + ko); }
                    else { ka0[j] = *(LAS const bf16x8*)(ka + (kq + j) * 32); ka1[j] = *(LAS const bf16x8*)(ka + 32 * KSTR + (kq + j) * 32); }
                    qq[j] = DIFF ? qf[DIFF ? j : 0] : *(LAS const bf16x8*)(qa + (kq + j) * 32); }
                __builtin_amdgcn_sched_barrier(0);
#pragma unroll
                for (int j = 0; j < 4; ++j) { s0 = __builtin_amdgcn_mfma_f32_32x32x16_bf16(ka0[j], qq[j], s0, 0, 0, 0); s1 = __builtin_amdgcn_mfma_f32_32x32x16_bf16(ka1[j], qq[j], s1, 0, 0, 0); }
            }
            float c0 = 0.f, c1 = 0.f;
            if (DIFF) {
                c0 = sl2 * (float)(64 * kt - wrow); c1 = sl2 * (float)(64 * kt + 32 - wrow);
                if (64 * kt + 64 > wrow) {
                    asm volatile("" ::: "memory");
                    const int irel = wrow + l32 - 64 * kt - hi * 4;
#pragma unroll
                    for (int r = 0; r < 16; ++r) { const int cr = (r >> 2) * 8 + (r & 3); if (cr > irel) s0[r] = -INFINITY; if (cr + 32 > irel) s1[r] = -INFINITY; }
                }
            }
            LAS const unsigned char* va = vb + (hi * 4 + ((lane & 15) >> 2)) * VSTR + (DIFF ? 0 : c * 256) + (((lane >> 4) & 1) * 16 + 4 * (lane & 3)) * 2;
            bf16x8 fa[4], fb[4];
            const int vq = (lane & 15) >> 2, vp = lane & 3, vg1 = (lane >> 4) & 1;
            const int vs0 = 256 * (hi * 4 + vq) + 16 * ((2 * vg1 + (vp >> 1)) ^ hi) + 8 * (vp & 1), vs1 = 256 * (hi * 4 + 8 + vq) + 16 * ((2 * vg1 + (vp >> 1)) ^ (hi + 2)) + 8 * (vp & 1);
#define ATT_LOADG(F, dvb) do { _Pragma("unroll") for (int j = 0; j < 4; ++j) { LAS const unsigned char* pp = va + (j * 16) * VSTR + (dvb) * 64; \
                LAS const unsigned char* p0 = DIFF ? vb + vs0 + 64 * ((dvb) ^ vq) + j * 4096 : pp; LAS const unsigned char* p1 = DIFF ? vb + vs1 + 64 * ((dvb) ^ vq) + j * 4096 : pp + 8 * VSTR; \
                const s16x4 lo = vtr(p0), h4 = vtr(p1); bf16x8 t_; t_[0] = lo[0]; t_[1] = lo[1]; t_[2] = lo[2]; t_[3] = lo[3]; t_[4] = h4[0]; t_[5] = h4[1]; t_[6] = h4[2]; t_[7] = h4[3]; F[j] = t_; } } while (0)
#define ATT_MMAG(F, dvb) do { _Pragma("unroll") for (int j = 0; j < 4; ++j) o[dvb] = __builtin_amdgcn_mfma_f32_32x32x16_bf16(F[j], pb[j >> 1][j & 1], o[dvb], 0, 0, 0); } while (0)
            float mx0 = s0[0], mx1 = s1[0];
#pragma unroll
            for (int r = 1; r < 16; r += 2) { mx0 = fmaxf(fmaxf(mx0, s0[r]), s0[r + 1 < 16 ? r + 1 : r]); mx1 = fmaxf(fmaxf(mx1, s1[r]), s1[r + 1 < 16 ? r + 1 : r]); }
            float mx = fmaxf(__builtin_fmaf(mx0, sc2, c0), __builtin_fmaf(mx1, sc2, c1));
            mx = fmaxf(mx, __shfl_xor(mx, 32));
            __builtin_amdgcn_sched_barrier(0);
            ATT_LOADG(fa, 0); ATT_LOADG(fb, 1);
            __builtin_amdgcn_sched_barrier(0);
            if (__builtin_amdgcn_ballot_w64(mx > m_run) != 0ull) {
                const float mnew = fmaxf(m_run, mx), alpha = __builtin_amdgcn_exp2f(m_run - mnew); m_run = mnew; l_run *= alpha;
#pragma unroll
                for (int i = 0; i < 4; ++i)
#pragma unroll
                    for (int r = 0; r < 16; ++r) o[i][r] *= alpha;
            }
            const float d0 = c0 - m_run, d1 = c1 - m_run;
            float rs0 = 0.f, rs1 = 0.f;
#pragma unroll
            for (int r = 0; r < 16; ++r) { s0[r] = __builtin_amdgcn_exp2f(__builtin_fmaf(s0[r], sc2, d0)); s1[r] = __builtin_amdgcn_exp2f(__builtin_fmaf(s1[r], sc2, d1)); rs0 += s0[r]; rs1 += s1[r]; }
            l_run += rs0 + rs1;
            bf16x8 pb[2][2];
#pragma unroll
            for (int g = 0; g < 2; ++g) {
                u32x4 w0, w1;
                w0.x = cvtpk(s0[8 * g], s0[8 * g + 1]); w0.y = cvtpk(s0[8 * g + 2], s0[8 * g + 3]); w0.z = cvtpk(s0[8 * g + 4], s0[8 * g + 5]); w0.w = cvtpk(s0[8 * g + 6], s0[8 * g + 7]);
                w1.x = cvtpk(s1[8 * g], s1[8 * g + 1]); w1.y = cvtpk(s1[8 * g + 2], s1[8 * g + 3]); w1.z = cvtpk(s1[8 * g + 4], s1[8 * g + 5]); w1.w = cvtpk(s1[8 * g + 6], s1[8 * g + 7]);
                pb[0][g] = __builtin_bit_cast(bf16x8, w0); pb[1][g] = __builtin_bit_cast(bf16x8, w1);
            }
            __builtin_amdgcn_sched_barrier(0);
            ATT_MMAG(fa, 0); ATT_LOADG(fa, 2); __builtin_amdgcn_sched_barrier(0); ATT_MMAG(fb, 1); ATT_LOADG(fb, 3); __builtin_amdgcn_sched_barrier(0); ATT_MMAG(fa, 2); ATT_MMAG(fb, 3);
#undef ATT_LOADG
#undef ATT_MMAG
        }
    }
    l_run += __shfl_xor(l_run, 32);
#undef ATT_GLOAD
#undef ATT_LSTORE
#undef ATT_DMA
    const float inv = 1.f / l_run;
    if (DIFF) {
        __syncthreads();
        LAS float* ex = (LAS float*)lds + (wid & 3) * 4096;
        if (c == 1) { const float f = inv * lam;
#pragma unroll
            for (int i = 0; i < 4; ++i)
#pragma unroll
                for (int r = 0; r < 16; ++r) ex[(i * 16 + r) * 64 + lane] = o[i][r] * f; }
        __syncthreads();
        if (c == 0) {
            float ss = 0.f;
#pragma unroll
            for (int i = 0; i < 4; ++i)
#pragma unroll
                for (int r = 0; r < 16; ++r) { const float v = o[i][r] * inv - ex[(i * 16 + r) * 64 + lane]; o[i][r] = v; ss += v * v; }
            ss += __shfl_xor(ss, 32);
            const float rstd = rsqrtf(ss * (1.f / 128.f) + 1e-6f) * oscale;
            LAS unsigned char* stg = (LAS unsigned char*)ex;
#pragma unroll
            for (int i = 0; i < 4; ++i)
#pragma unroll
                for (int r4 = 0; r4 < 4; ++r4) { const int dv = i * 32 + r4 * 8 + hi * 4; const f32x4 gg = *(const f32x4*)(subg + dv); u32x2 w;
                    w.x = cvtpk(o[i][4 * r4] * rstd * gg[0], o[i][4 * r4 + 1] * rstd * gg[1]); w.y = cvtpk(o[i][4 * r4 + 2] * rstd * gg[2], o[i][4 * r4 + 3] * rstd * gg[3]);
                    *(LAS u32x2*)(stg + l32 * 272 + dv * 2) = w; }
#pragma unroll
            for (int j = 0; j < 8; ++j) { const int row = j * 4 + (lane >> 4), ch = lane & 15;
                *(u32x4*)(Op + (size_t)(qr + row) * opitch + ch * 8) = *(LAS const u32x4*)(stg + row * 272 + ch * 16); }
        }
    } else {
        bf16_t* orow = Op + (size_t)(qr + l32) * opitch + c * 128;
#pragma unroll
        for (int i = 0; i < 4; ++i)
#pragma unroll
            for (int r4 = 0; r4 < 4; ++r4) { const int dv = i * 32 + r4 * 8 + hi * 4; u32x2 w;
                w.x = cvtpk(o[i][4 * r4] * inv, o[i][4 * r4 + 1] * inv); w.y = cvtpk(o[i][4 * r4 + 2] * inv, o[i][4 * r4 + 3] * inv);
                *(u32x2*)(orow + dv) = w; }
    }
}

__device__ void conv_unit(LAS unsigned char* lds, const bf16_t* __restrict__ Z, bf16_t* __restrict__ MIX, int unit,
                          const float* __restrict__ ccw, const float* __restrict__ ccb, const float* __restrict__ lng, const float* __restrict__ lnb, const float* __restrict__ scw) {
    LAS float* ub = (LAS float*)lds;
    const int tid = tid_opq(), t0 = unit * 64, tpos0 = t0 & (SEQ - 1);
    __syncthreads();
#define SG(x) __builtin_amdgcn_rcpf(1.f + __builtin_amdgcn_exp2f((x) * -1.4426950408889634f))
    { u32x4 cav[6], cgv[6];
#pragma unroll
      for (int i = 0; i < 6; ++i) { const int id = tid + 512 * i, row = id >> 5, c8 = (id & 31) * 8; int gr = t0 - 30 + row; gr = gr < 0 ? 0 : gr; gr = gr > MTOK - 1 ? MTOK - 1 : gr;
          const bf16_t* zr = Z + (size_t)gr * DIN + 1536 + c8; cav[i] = *(const u32x4*)zr; cgv[i] = *(const u32x4*)(zr + 256); }
#pragma unroll
      for (int i = 0; i < 6; ++i) { const int id = tid + 512 * i, row = id >> 5, c8 = (id & 31) * 8, tp = tpos0 - 30 + row; const u32x4 ca = cav[i], cg = cgv[i];
          f32x4 a, b;
          a[0] = bflo(ca.x) * SG(bflo(cg.x)); a[1] = bfhi(ca.x) * SG(bfhi(cg.x)); a[2] = bflo(ca.y) * SG(bflo(cg.y)); a[3] = bfhi(ca.y) * SG(bfhi(cg.y));
          b[0] = bflo(ca.z) * SG(bflo(cg.z)); b[1] = bfhi(ca.z) * SG(bfhi(cg.z)); b[2] = bflo(ca.w) * SG(bflo(cg.w)); b[3] = bfhi(ca.w) * SG(bfhi(cg.w));
          if (tp < 0) { a = (f32x4){0.f, 0.f, 0.f, 0.f}; b = a; }
          if (id < 94 * 32) { *(LAS f32x4*)(ub + row * 256 + c8) = a; *(LAS f32x4*)(ub + row * 256 + c8 + 4) = b; } } }
#undef SG
    __syncthreads();
    { const int ch = tid & 255, half = tid >> 8; float acc[32]; const float bias = ccb[ch];
#pragma unroll
      for (int j = 0; j < 32; ++j) acc[j] = bias;
      for (int k = 0; k < 31; ++k) { const float w = ccw[k * 256 + ch]; LAS const float* up = ub + (half * 32 + k) * 256 + ch;
#pragma unroll
          for (int j = 0; j < 32; ++j) acc[j] = __builtin_fmaf(w, up[j * 256], acc[j]); }
      __syncthreads();
#pragma unroll
      for (int j = 0; j < 32; ++j) ub[(half * 32 + j) * 256 + ch] = acc[j]; }
    __syncthreads();
    { const int wid = tid >> 6, lane = tid & 63; const f32x4 gg = *(const f32x4*)(lng + lane * 4), bb = *(const f32x4*)(lnb + lane * 4);
      for (int j = 0; j < 8; ++j) { const int tok = wid * 8 + j; const f32x4 y = *(LAS const f32x4*)(ub + tok * 256 + lane * 4);
          const float mean = wave_sum(y[0] + y[1] + y[2] + y[3]) * (1.f / 256.f); const f32x4 d = y - mean;
          const float var = wave_sum(d[0] * d[0] + d[1] * d[1] + d[2] * d[2] + d[3] * d[3]) * (1.f / 256.f), rstd = rsqrtf(var + 1e-6f);
          const f32x4 z = d * rstd * gg + bb; u32x2 w; w.x = cvtpk(silu_f(z[0]), silu_f(z[1])); w.y = cvtpk(silu_f(z[2]), silu_f(z[3]));
          *(u32x2*)(MIX + (size_t)(t0 + tok) * DM + 512 + lane * 4) = w; } }
#pragma unroll 2
    for (int i = 0; i < 4; ++i) { const int id = tid + 512 * i, tok = id >> 5, c8 = (id & 31) * 8, tp = tpos0 + tok; const bf16_t* zr = Z + (size_t)(t0 + tok) * DIN + 2048 + c8;
        u32x4 gcv[3], hsv[3];
#pragma unroll
        for (int k = 0; k < 3; ++k) { int back = 2 - k; back = (t0 + tok - back < 0) ? 0 : back; const bf16_t* zk = zr - (size_t)back * DIN; gcv[k] = *(const u32x4*)(zk + 256); hsv[k] = *(const u32x4*)(zk + 512); }
        const u32x4 gb = *(const u32x4*)zr;
        float y[8];
#pragma unroll
        for (int e = 0; e < 8; ++e) y[e] = 0.f;
#pragma unroll
        for (int k = 0; k < 3; ++k) { const u32x4 gc = gcv[k], hs = hsv[k]; const float on = (tp - 2 + k >= 0) ? 1.f : 0.f;
                const f32x4 w0 = *(const f32x4*)(scw + k * 256 + c8) * on, w1 = *(const f32x4*)(scw + k * 256 + c8 + 4) * on;
                y[0] += w0[0] * bflo(gc.x) * bflo(hs.x); y[1] += w0[1] * bfhi(gc.x) * bfhi(hs.x); y[2] += w0[2] * bflo(gc.y) * bflo(hs.y); y[3] += w0[3] * bfhi(gc.y) * bfhi(hs.y);
                y[4] += w1[0] * bflo(gc.z) * bflo(hs.z); y[5] += w1[1] * bfhi(gc.z) * bfhi(hs.z); y[6] += w1[2] * bflo(gc.w) * bflo(hs.w); y[7] += w1[3] * bfhi(gc.w) * bfhi(hs.w); }
        u32x4 w;
        w.x = cvtpk(bflo(gb.x) * y[0], bfhi(gb.x) * y[1]); w.y = cvtpk(bflo(gb.y) * y[2], bfhi(gb.y) * y[3]); w.z = cvtpk(bflo(gb.z) * y[4], bfhi(gb.z) * y[5]); w.w = cvtpk(bflo(gb.w) * y[6], bfhi(gb.w) * y[7]);
        *(u32x4*)(MIX + (size_t)(t0 + tok) * DM + 768 + c8) = w; }
}
#ifndef PROBE_SYNC
#define PROBE_SYNC 0
#endif
#ifndef PROBE_MASK
#define PROBE_MASK 0
#endif

struct Params { const float* in[29]; float* out; unsigned char* ws; int ph_lo, ph_hi, fused_final, pad_; };
constexpr size_t MiB = 1u << 20;
constexpr size_t WS_W = 0, WS_CTL = 97 * MiB, CTL_BYTES = 32768, WS_XB0 = WS_CTL + 65536, WS_XB1 = WS_XB0 + 32 * MiB, WS_BIG = WS_XB1 + 32 * MiB, WS_KV = WS_BIG + 88 * MiB, WS_PS = WS_KV + 8 * MiB, WS_END2 = WS_PS + 1 * MiB;
constexpr size_t WS_MEMN = WS_XB1;
constexpr size_t WO_GU1 = 0, WO_D1 = WO_GU1 + (size_t)5632 * 1024, WO_IN = WO_D1 + (size_t)1024 * 2816, WO_OUT = WO_IN + (size_t)2816 * 1024, WO_Q = WO_OUT + (size_t)1024 * 1024,
                 WO_KV = WO_Q + (size_t)1024 * 1024, WO_O = WO_KV + (size_t)2048 * 1024, WO_GU2 = WO_O + (size_t)1024 * 1024, WO_D2 = WO_GU2 + (size_t)5632 * 1024, WO_LAYER = WO_D2 + (size_t)1024 * 2816;
static_assert(2 * WO_LAYER * 2 <= WS_CTL && WS_END2 <= 262 * MiB, "workspace map");
constexpr int N_PHASES = 20, PPL = 9;
#define XB_TMO      128
#define XB_XCNT(j)  (256  + 64 * (j))
#define XB_XSUB(j)  (1280 + 64 * (j))
#define XB_XGEN(j)  (2304 + 64 * (j))
#define XB_TOP      3328
#define XB_TOPGEN   3392
#define XCD_BAR_WORDS 3456
#define XB_SPIN_CAP (1u << 18)

__device__ __forceinline__ unsigned xb_ld(unsigned* p)              { return __hip_atomic_load(p, __ATOMIC_RELAXED, __HIP_MEMORY_SCOPE_AGENT); }
__device__ __forceinline__ unsigned xb_add(unsigned* p, unsigned v) { return __hip_atomic_fetch_add(p, v, __ATOMIC_RELAXED, __HIP_MEMORY_SCOPE_AGENT); }
__device__ __forceinline__ unsigned xb_xcc_id() { return (unsigned)__builtin_amdgcn_s_getreg((3 << 11) | 20) & 0xFu; }
#define XB_SPIN(cond, bar) do { unsigned _sp = 0; while (cond) { __builtin_amdgcn_s_sleep(1); \
    if ((++_sp & 255u) == 0u) { if (xb_ld(&(bar)[XB_TMO])) break; if (_sp > XB_SPIN_CAP) { atomicAdd(&(bar)[XB_TMO], 1u); break; } } } } while (0)

struct XcdBarrier {
    unsigned* bar; unsigned x;
    volatile LAS unsigned* st;
};

__device__ __forceinline__ XcdBarrier xcd_barrier_post(unsigned* bar, volatile LAS unsigned* st) {
    XcdBarrier b; b.bar = bar; b.x = xb_xcc_id(); b.st = st;
    if (threadIdx.x == 0) (void)xb_add(&bar[XB_XCNT(b.x)], 1u);
    return b;
}
__device__ __forceinline__ void xcd_barrier_complete(unsigned* bar, unsigned x, unsigned& nloc, unsigned& nx) {
    const unsigned G = gridDim.x * gridDim.y * gridDim.z;
    unsigned sum, cnt, mine, sp = 0u;
    for (;;) {
        sum = 0u; cnt = 0u; mine = 0u;
#pragma unroll
        for (unsigned j = 0; j < 16; ++j) { const unsigned c = xb_ld(&bar[XB_XCNT(j)]); sum += c; cnt += (c > 0u) ? 1u : 0u; mine = (j == x) ? c : mine; }
        if (sum == G) break;
        __builtin_amdgcn_s_sleep(1);
        if ((++sp & 255u) == 0u) { if (xb_ld(&bar[XB_TMO])) break; if (sp > XB_SPIN_CAP) { atomicAdd(&bar[XB_TMO], 1u); break; } }
    }
    nloc = mine > 0u ? mine : 1u; nx = cnt > 0u ? cnt : 1u;
}

__device__ __forceinline__ void xcd_barrier(const XcdBarrier& b) {
    asm volatile("s_waitcnt vmcnt(0)" ::: "memory");
    __syncthreads();
    if (threadIdx.x == 0) {
        unsigned* bar = b.bar;
        __builtin_amdgcn_s_waitcnt(0);
        unsigned nloc = b.st[0], nx = b.st[1];
        if (nloc == 0u) { xcd_barrier_complete(bar, b.x, nloc, nx); b.st[0] = nloc; b.st[1] = nx; }
        const unsigned old = xb_add(&bar[XB_XSUB(b.x)], 1u);
        const unsigned gen = old / nloc;
        if (old + 1u == (gen + 1u) * nloc) {
            __builtin_amdgcn_fence(__ATOMIC_RELEASE, "agent");
            asm volatile("s_waitcnt vmcnt(0)" ::: "memory");
            const unsigned og = xb_add(&bar[XB_TOP], 1u);
            const unsigned tg = og / nx;
            if (og + 1u == (tg + 1u) * nx) xb_add(&bar[XB_TOPGEN], 1u);
            else XB_SPIN(xb_ld(&bar[XB_TOPGEN]) == tg, bar);
            __builtin_amdgcn_fence(__ATOMIC_ACQUIRE, "agent");
            xb_add(&bar[XB_XGEN(b.x)], 1u);
            asm volatile("s_waitcnt vmcnt(0)" ::: "memory");
        } else {
            XB_SPIN(xb_ld(&bar[XB_XGEN(b.x)]) == gen, bar);
            __builtin_amdgcn_fence(__ATOMIC_ACQUIRE, "agent");
            asm volatile("s_waitcnt vmcnt(0)" ::: "memory");
        }
    }
    __syncthreads();
}


__device__ __forceinline__ void run_phase(const Params& p, LAS unsigned char* lds, int ph, bool dummy) {
    bf16_t* WB = (bf16_t*)(p.ws + WS_W); bf16_t* XB0 = (bf16_t*)(p.ws + WS_XB0); bf16_t* XB1 = (bf16_t*)(p.ws + WS_XB1); bf16_t* BIG = (bf16_t*)(p.ws + WS_BIG); bf16_t* KV = (bf16_t*)(p.ws + WS_KV); bf16_t* MEMN = (bf16_t*)(p.ws + WS_MEMN);
    float* RSA = (float*)(p.ws + WS_PS); float* RSB = RSA + MTOK;
    bf16_t* OXA = BIG + (size_t)MTOK * DM;
    float* X = p.out;
    if (ph == 0) {
        {
            bf16_t* wl = WB;
            cvt_w(lds, p.in[3], DM, DFF, wl + WO_GU1, 1, p.in[2]); cvt_w(lds, p.in[4], DM, DFF, wl + WO_GU1, 2, p.in[2]);
            cvt_w(lds, p.in[5], DFF, DM, wl + WO_D1, 0, nullptr, 0, 0, 0.5f);
            cvt_w(lds, p.in[7], DM, DIN, wl + WO_IN, 0, p.in[6]);
            cvt_w(lds, p.in[18], DM, DM, wl + WO_OUT, 0);
            cvt_w(lds, p.in[21], DM, DM, wl + WO_Q, 0, p.in[19]);
            cvt_w(lds, p.in[23], DM, DM, wl + WO_O, 0);
            cvt_w(lds, p.in[25], DM, DFF, wl + WO_GU2, 1, p.in[24]); cvt_w(lds, p.in[26], DM, DFF, wl + WO_GU2, 2, p.in[24]);
            cvt_w(lds, p.in[27], DFF, DM, wl + WO_D2, 0, nullptr, 0, 0, 0.5f);
        }
#pragma unroll 1
        for (int l = 0; l < DEPTH; ++l) {
            cvt_w(lds, p.in[22] + (size_t)l * DM * 2048, DM, 2048, WB + l * WO_LAYER + WO_KV, 0);
            norm_rows_bf16(p.in[1], p.in[20] + l * DM, MEMN + (size_t)l * MMEM * DM, MMEM);
        }
        prep_rows(p.in[0], XB0, RSA, MTOK);
        for (int i = bid_opq() * 512 + tid_opq(); i < MTOK; i += gridDim.x * 512) RSB[i] = 0.f;
        return;
    }
    if (ph == N_PHASES - 1) { final_rows(XB0, XB1, p.out, RSA, p.in[28], MTOK); return; }
    const int l = (ph - 1) / PPL, s = (ph - 1) % PPL;
    bf16_t* wl = WB + l * WO_LAYER;
    const float lam_init = l == 0 ? 0.2f : 0.35550907f;
    int kind = 0, nstore = 0; const bf16_t* A = XB0; const bf16_t* Bt = wl; int N = DM, K = DM; bf16_t* Ob = BIG; int ldc = DM; const float* Xin = X; float scale = 1.f;
    switch (s) {
    case 0: kind = 2; Bt = wl + WO_GU1; N = 5632; ldc = DFF; if (l == 0) nstore = 2; break;
    case 1: kind = 3; A = BIG; Bt = wl + WO_D1; K = DFF; Xin = (l == 0) ? p.in[0] : X; scale = 0.5f; break;
    case 2: nstore = 1; Bt = wl + WO_IN; N = DIN; ldc = DIN; break;
    case 3: {
        const int lane = tid_opq() & 63;
        float a = p.in[8][l * 64 + lane] * p.in[9][l * 64 + lane], b = p.in[10][l * 64 + lane] * p.in[11][l * 64 + lane];
        a = wave_sum(a); b = wave_sum(b);
        const float lam = __expf(a) - __expf(b) + lam_init;
        const bf16_t* Z = BIG;
#pragma unroll 1
        for (int pj = bid_opq(); pj < 256; pj += gridDim.x) { const int bh = (pj & 7) * 2 + (pj >> 7), xp = (pj >> 3) & 15, b_ = bh >> 2, h = bh & 3; const float sl2 = exp2f(-2.f * (float)(h + 1)) * LOG2E;
#pragma unroll 1
            for (int rep = 0; rep < 2; ++rep) { const int x = rep ? xp : 31 - xp; const bf16_t* zb = Z + (size_t)(b_ * SEQ) * DIN + h * 128;
                attn_unit<true>(lds, zb + (size_t)(x * 128) * DIN, DIN, zb + 512, zb + 1024, DIN, 2 * (x + 1), x * 128, 0.125f * LOG2E, sl2, lam,
                                XB1 + (size_t)(b_ * SEQ + x * 128) * DM + h * 128, DM, p.in[12] + l * 128, 1.f - lam_init); } }
#pragma unroll 1
        for (int u = bid_opq(); u < MTOK / 64; u += gridDim.x) conv_unit(lds, Z, XB1, u, p.in[13] + l * 31 * 256, p.in[14] + l * 256, p.in[15] + l * 256, p.in[16] + l * 256, p.in[17] + l * 3 * 256);
    } break;
    case 4: kind = 3; A = XB1; Bt = wl + WO_OUT; break;
    case 5: nstore = 1; Bt = wl + WO_Q; break;
    case 6: kind = 3; A = OXA; Bt = wl + WO_O; break;
    case 7: kind = 2; Bt = wl + WO_GU2; N = 5632; ldc = DFF; break;
    case 8: kind = 3; A = BIG; Bt = wl + WO_D2; K = DFF; scale = 0.5f; break;
    }
    const bool consA = (s == 0 || s == 5);
    float* rs_in = consA ? RSA : RSB; float* rs_zero = consA ? RSB : RSA; float* rs_acc = (s == 1 || s == 6) ? RSB : RSA;
    if (kind == 2 || nstore) { for (int i = bid_opq() * 512 + tid_opq(); i < MTOK; i += gridDim.x * 512) rs_zero[i] = 0.f; }
    if (kind == 2) { EpiSwiglu E; E.O = BIG; E.ldc = DFF; E.RS = rs_in; E.pad_ = 0; run_gemm(lds, A, Bt, MTOK, N, K, E); }
#pragma unroll 1
    for (int rep = 0; rep < nstore; ++rep) {
        EpiStore E; E.O = Ob; E.ldc = ldc; E.RS = rs_in; E.pad_ = 0; int M = MTOK, off = 0; const bf16_t* a2 = A; const bf16_t* b2 = Bt; int n2 = N;
        if (s == 0) { a2 = MEMN + (size_t)rep * MMEM * DM; b2 = WB + rep * WO_LAYER + WO_KV; M = MMEM; n2 = 2048; E.O = KV + (size_t)rep * MMEM * 2048; E.ldc = 2048; E.RS = nullptr; off = 128 + 32 * rep; }
        run_gemm(lds, a2, b2, M, n2, K, E, off);
    }
    if (s == 5 && !dummy) {
        asm volatile("s_waitcnt vmcnt(0)" ::: "memory"); __syncthreads();
        const bf16_t* kvl = KV + (size_t)l * MMEM * 2048;
        OffOrder S; S.init(MTOK, DM, (int)gridDim.x, bid_opq(), 0); Unit u;
#pragma unroll 1
        for (int i = 0; S.next(i, u); ++i) {
#pragma unroll 1
            for (int hh = 0; hh < 2; ++hh) { const int row = u.pm * 256 + hh * 128, b_ = row / SEQ, h = u.pn; const size_t qo = (size_t)row * DM + h * 256;
                const bf16_t* kp = kvl + (size_t)(b_ * MEML) * 2048 + h * 256;
                attn_unit<false>(lds, BIG + qo, DM, kp, kp + 1024, 2048, 4, 0, 0.0625f * LOG2E, 0.f, 0.f, OXA + qo, DM, nullptr, 1.f); } }
    }
    if (l == 0 && !dummy) { bf16_t* w1 = WB + WO_LAYER; const int bid = bid_opq();
        if (s == 0 && bid >= 192) { cvt_w(lds, p.in[5] + (size_t)DM * DFF, DFF, DM, w1 + WO_D1, 0, nullptr, 192, 64, 0.5f); cvt_w(lds, p.in[18] + (size_t)DM * DM, DM, DM, w1 + WO_OUT, 0, nullptr, 192, 64); }
        if (s == 2 && bid >= 192) { cvt_w(lds, p.in[7] + (size_t)DM * DIN, DM, DIN, w1 + WO_IN, 0, p.in[6] + DM, 192, 64); cvt_w(lds, p.in[21] + (size_t)DM * DM, DM, DM, w1 + WO_Q, 0, p.in[19] + DM, 192, 64); }
        if (s == 7 && bid >= 128) { cvt_w(lds, p.in[3] + (size_t)DM * DFF, DM, DFF, w1 + WO_GU1, 1, p.in[2] + DM, 128, 128); cvt_w(lds, p.in[4] + (size_t)DM * DFF, DM, DFF, w1 + WO_GU1, 2, p.in[2] + DM, 128, 128);
                                    cvt_w(lds, p.in[23] + (size_t)DM * DM, DM, DM, w1 + WO_O, 0, nullptr, 128, 128); cvt_w(lds, p.in[27] + (size_t)DM * DFF, DFF, DM, w1 + WO_D2, 0, nullptr, 128, 128, 0.5f); }
    }
    if (l == 1 && s == 0 && !dummy && bid_opq() >= 128) { bf16_t* w1 = WB + WO_LAYER;
        cvt_w(lds, p.in[25] + (size_t)DM * DFF, DM, DFF, w1 + WO_GU2, 1, p.in[24] + DM, 128, 128); cvt_w(lds, p.in[26] + (size_t)DM * DFF, DM, DFF, w1 + WO_GU2, 2, p.in[24] + DM, 128, 128); }
    bf16_t* LOD = (bf16_t*)p.out;
    HiLoIn hin; hin.Xin32 = (l == 0 && s == 1) ? p.in[0] : nullptr; hin.HiIn = XB0; hin.LoIn = (l == DEPTH - 1 && s == PPL - 1) ? XB1 : LOD;
    bf16_t* lo_out = (l == DEPTH - 1 && s >= 6) ? XB1 : LOD;
    if (kind == 3 && ph == N_PHASES - 2 && p.fused_final) {
        EpiFinal E; E.in = hin; E.Out = p.out; E.RS = rs_acc; E.g = p.in[28]; E.cnt = (unsigned*)(p.ws + WS_CTL) + 3584; run_gemm(lds, A, Bt, MTOK, N, K, E); kind = 0; }
    if (kind == 3) { EpiResid E; E.in = hin; E.HiOut = XB0; E.LoOut = lo_out; E.RS = rs_acc; run_gemm(lds, A, Bt, MTOK, N, K, E); }
}

__global__ void __launch_bounds__(512) mega_kernel(Params p) {
    extern __shared__ __attribute__((aligned(16))) unsigned char smem[];
    LAS unsigned char* lds = (LAS unsigned char*)smem;
    volatile LAS unsigned* st = (volatile LAS unsigned*)(lds + LDS_BYTES - 64);
    if (threadIdx.x == 0) { st[0] = 0u; st[1] = 0u; }
    __syncthreads();
    const XcdBarrier xb = xcd_barrier_post((unsigned*)(p.ws + WS_CTL), st);
    cg::grid_group grid = cg::this_grid();
    if (p.ph_lo < 0) grid.sync();
#pragma unroll 1
    for (int ph = p.ph_lo; ph < p.ph_hi; ++ph) {
        if (ph > p.ph_lo) xcd_barrier(xb);
#if PROBE_SYNC
        xcd_barrier(xb);
#endif
        int dup = 0;
#if PROBE_MASK
        { const int s = (ph - 1) % PPL; const bool mid = ph > 0 && ph < N_PHASES - 1;
          if ((PROBE_MASK & 1) && mid && (s == 0 || s == 8)) dup = 1;
          if ((PROBE_MASK & 2) && mid && (s == 2 || s == 5)) dup = 1;
          if ((PROBE_MASK & 4) && mid && (s == 1 || s == 4 || s == 7 || s == 9)) dup = 1;
          if ((PROBE_MASK & 8) && mid && s == 3) dup = 1;
          if ((PROBE_MASK & 16) && mid && s == 6) dup = 1;
          if ((PROBE_MASK & 32) && ph == 0) dup = 1; }
#endif
#pragma unroll 1
        for (int rep = dup ? 0 : 1; rep < 2; ++rep) run_phase(p, lds, ph, rep == 0);
    }
}

#ifndef MK_PER_PHASE
#define MK_PER_PHASE 0
#endif
extern "C" void kernel_launch(void* const* d_in, const int* in_sizes, int n_in, void* d_out, int out_size, void* d_ws, size_t ws_size, hipStream_t stream) {
    static int grid = 0;
    if (grid == 0) {
        if (n_in != 29 || out_size != MTOK * DM || ws_size < WS_END2) { fprintf(stderr, "kernel_launch: unexpected shapes n_in %d out %d ws %zu\n", n_in, out_size, ws_size); grid = -1; return; }
        int dev = 0, cus = 0, per_cu = 0;
        hipGetDevice(&dev); hipDeviceGetAttribute(&cus, hipDeviceAttributeMultiprocessorCount, dev);
        if (hipFuncSetAttribute((const void*)mega_kernel, hipFuncAttributeMaxDynamicSharedMemorySize, LDS_BYTES) != hipSuccess) { fprintf(stderr, "kernel_launch: hipFuncSetAttribute failed\n"); grid = -1; return; }
        if (hipOccupancyMaxActiveBlocksPerMultiprocessor(&per_cu, (const void*)mega_kernel, 512, LDS_BYTES) != hipSuccess || per_cu < 1) { fprintf(stderr, "kernel_launch: occupancy query says %d\n", per_cu); per_cu = 1; }
        (void)hipGetLastError();
        grid = cus * 1;
        fprintf(stderr, "kernel_launch: cus %d per_cu %d grid %d\n", cus, per_cu, grid);
    }
    if (grid < 0) return;
    if (hipMemsetAsync((char*)d_ws + WS_CTL, 0, CTL_BYTES, stream) != hipSuccess) { fprintf(stderr, "kernel_launch: memset failed\n"); return; }
    Params p{};
    for (int i = 0; i < 29; ++i) p.in[i] = (const float*)d_in[i];
    p.out = (float*)d_out; p.ws = (unsigned char*)d_ws;
#if MK_PER_PHASE
    for (int ph = 0; ph < N_PHASES; ++ph) { p.ph_lo = ph; p.ph_hi = ph + 1; void* args[] = {&p};
        hipError_t e = hipLaunchCooperativeKernel((const void*)mega_kernel, dim3(grid), dim3(512), args, LDS_BYTES, stream);
        if (e != hipSuccess) { fprintf(stderr, "kernel_launch: launch %d failed: %s\n", ph, hipGetErrorString(e)); break; } }
#else
    p.fused_final = (grid == 256) ? 1 : 0;
    p.ph_lo = 0; p.ph_hi = p.fused_final ? N_PHASES - 1 : N_PHASES; void* args[] = {&p};
    hipError_t e = hipLaunchCooperativeKernel((const void*)mega_kernel, dim3(grid), dim3(512), args, LDS_BYTES, stream);
    if (e != hipSuccess) fprintf(stderr, "kernel_launch: cooperative launch failed: %s (grid %d)\n", hipGetErrorString(e), grid);
#endif
}
```

```cpp
#include <hip/hip_runtime.h>
#include <hip/hip_cooperative_groups.h>
#include <cstdio>
#include <cstdint>
namespace cg = cooperative_groups;
__device__ __forceinline__ int tid_opq() { int t = threadIdx.x; asm volatile("" : "+v"(t)); return t; }
__device__ __forceinline__ int bid_opq() { int b = blockIdx.x; asm volatile("" : "+s"(b)); return b; }
namespace pg8 {
#define PG8_LAS __attribute__((address_space(3)))
typedef unsigned short bf16_t;
typedef short bf16x8 __attribute__((ext_vector_type(8)));
typedef float f32x4 __attribute__((ext_vector_type(4)));
typedef unsigned u32x4 __attribute__((ext_vector_type(4)));
constexpr int BM = 256, BK = 64, HALF = 128, HTB = HALF * BK * 2  , STAGE_BYTES = 8 * HTB, NXCD = 8, WGM = 8;

__host__ __device__ __forceinline__ int lds_byte(int r, int c) { const int st = (r >> 4) * 2 + (c >> 5), rr = r & 15, cc = c & 31, ob = rr * 64 + cc * 2; return st * 1024 + (ob ^ (((ob >> 9) & 1) << 5)); }
__host__ __device__ __forceinline__ void stage_rc(int b, int& R, int& C) { const int st = b / 1024, sb = b % 1024, swz = sb ^ (((sb >> 9) & 1) << 5); R = (st >> 1) * 16 + swz / 64; C = (st & 1) * 32 + (swz % 64) / 2; }
__host__ __device__ __forceinline__ int perm32(int rho) { const int n = rho >> 4, i = rho & 15; return 8 * (i >> 2) + 4 * n + (i & 3); }

struct Unit { int pm, pn; };
struct Gemm { const bf16_t* A; const bf16_t* Bt; int M, N, K, krev; };

struct StaticOrder {
    int nM, nN, nwg, G, c;
    __host__ __device__ void init(int M, int N, int G_, int c_) { nM = M / BM; nN = N / BM; nwg = nM * nN; G = G_; c = c_; }
    __host__ __device__ bool next(int i, Unit& u) const {
        const long L = (long)i * G + c; if (L >= nwg) return false;
        int wgid = (int)L; { const int q = nwg / NXCD, r = nwg % NXCD, xcd = wgid % NXCD, off = wgid / NXCD; wgid = (xcd < r ? xcd * (q + 1) : r * (q + 1) + (xcd - r) * q) + off; }
        const int nig = WGM * nN, gid = wgid / nig, fm = gid * WGM, gsz = (nM - fm) < WGM ? (nM - fm) : WGM;
        u.pm = fm + ((wgid % nig) % gsz); u.pn = (wgid % nig) / gsz; return true;
    }
    __device__ __forceinline__ void a_ready(const Unit&) const {}
    __device__ __forceinline__ void done(const Unit&) const {}
};
__device__ __forceinline__ unsigned cvt_pk_bf16(float lo, float hi) { unsigned r; asm volatile("v_cvt_pk_bf16_f32 %0, %1, %2" : "=v"(r) : "v"(lo), "v"(hi)); return r; }
template <class Epi, class Sched, bool ALIGN_EPI = false, bool SP2 = false>
__device__ __forceinline__ void gemm_phase(PG8_LAS unsigned char* lds, const Gemm g, const Sched S, const Epi E) {
    const int tid = tid_opq(), wid = __builtin_amdgcn_readfirstlane(tid >> 6), lane = tid & 63, wr = wid >> 2, wc = wid & 3, fr = lane & 15, fq = lane >> 4;
    const int K = g.K, nt = K / BK;
    unsigned voffA[2], voffB[2];
#pragma unroll
    for (int i = 0; i < 2; ++i) { int R, C; stage_rc(tid * 16 + i * 8192, R, C); const int Rb = Epi::PERM ? ((R & ~31) + perm32(R & 31)) : R;
        voffA[i] = (unsigned)(R * K + C) * 2u; voffB[i] = (unsigned)(Rb * K + C) * 2u; }
    const long kstep = g.krev ? -(long)(BK * 2) : (long)(BK * 2);
    const size_t kbase = g.krev ? (size_t)(K / BK - 1) * (BK * 2) : 0;
    const size_t hstep = (size_t)HALF * K * 2;
    const size_t tstep = 2 * hstep;
    const unsigned ldsw = (unsigned)wid * 1024u;
    const int aoff = lds_byte(wr * 64 + fr, fq * 8), boff = lds_byte(wc * 32 + fr, fq * 8);
#define PG8_SA(b, h) (((b) * 2 + (h)) * HTB)
#define PG8_SB(b, h) ((4 + (b) * 2 + (h)) * HTB)
#define PG8_STAGE(bufoff, gbase, voff) do { _Pragma("unroll") for (int _i = 0; _i < 2; ++_i) \
        __builtin_amdgcn_global_load_lds((const unsigned*)((const char*)(gbase) + (voff)[_i]), (PG8_LAS unsigned*)(lds + (bufoff) + ldsw + _i * 8192), 16, 0, 0); } while (0)
#define PG8_LDA(dst, b, h) do { _Pragma("unroll") for (int m = 0; m < 4; ++m) _Pragma("unroll") for (int k = 0; k < 2; ++k) dst[m][k] = *(const PG8_LAS bf16x8*)(lds + PG8_SA(b, h) + aoff + m * 2048 + k * 1024); } while (0)
#define PG8_LDB(dst, b, h) do { _Pragma("unroll") for (int n = 0; n < 2; ++n) _Pragma("unroll") for (int k = 0; k < 2; ++k) dst[n][k] = *(const PG8_LAS bf16x8*)(lds + PG8_SB(b, h) + boff + n * 2048 + k * 1024); } while (0)
#define PG8_MMA(ai, bj, At, Bt) do { __builtin_amdgcn_s_setprio(1); _Pragma("unroll") for (int m = 0; m < 4; ++m) _Pragma("unroll") for (int n = 0; n < 2; ++n) _Pragma("unroll") for (int k = 0; k < 2; ++k) \
        acc[ai][bj][m][n] = __builtin_amdgcn_mfma_f32_16x16x32_bf16(Bt[n][k], At[m][k], acc[ai][bj][m][n], 0, 0, 0); __builtin_amdgcn_s_setprio(0); } while (0)
#define PG8_WAIT_V(n) asm volatile("s_waitcnt vmcnt(" #n ")" ::: "memory")
#define PG8_WAIT_L(n) asm volatile("s_waitcnt lgkmcnt(" #n ")" ::: "memory")
#define PG8_BAR __builtin_amdgcn_s_barrier()
#define PG8_SCHED __builtin_amdgcn_sched_barrier(0)
    Unit cur, nxt; int ui = 0;
    if (!S.next(0, cur)) return;
    f32x4 acc[2][2][4][2];
    E.init_acc(acc, cur, wr, wc, fr, fq);
    bf16x8 At[4][2], B0[2][2], B1[2][2];
    const char* cA = (const char*)g.A + (size_t)cur.pm * tstep + kbase; const char* cB = (const char*)g.Bt + (size_t)cur.pn * tstep + kbase;
    S.a_ready(cur);
    float pre[8]; E.prefetch(cur, wr, fr, pre);
    if constexpr (SP2) {
        PG8_STAGE(PG8_SB(0, 0), cB, voffB); PG8_STAGE(PG8_SB(0, 1), cB + hstep, voffB); PG8_STAGE(PG8_SA(0, 0), cA, voffA); PG8_STAGE(PG8_SA(0, 1), cA + hstep, voffA);
        if (wr == 1) PG8_BAR;
        PG8_WAIT_V(2); PG8_BAR;
        PG8_STAGE(PG8_SB(1, 0), cB + kstep, voffB); PG8_STAGE(PG8_SA(1, 0), cA + kstep, voffA); PG8_STAGE(PG8_SB(1, 1), cB + hstep + kstep, voffB);
        PG8_WAIT_V(6); PG8_BAR;
    } else {
        PG8_STAGE(PG8_SB(0, 0), cB, voffB); PG8_STAGE(PG8_SA(0, 0), cA, voffA); PG8_STAGE(PG8_SB(0, 1), cB + hstep, voffB); PG8_STAGE(PG8_SA(0, 1), cA + hstep, voffA);
        if (wr == 1) PG8_BAR;
        PG8_WAIT_V(4); PG8_BAR;
        PG8_STAGE(PG8_SB(1, 0), cB + kstep, voffB); PG8_STAGE(PG8_SA(1, 0), cA + kstep, voffA); PG8_STAGE(PG8_SB(1, 1), cB + hstep + kstep, voffB);
        PG8_WAIT_V(6); PG8_BAR;
    }
    E.settle(acc);
    for (;;) {
        const bool has_next = S.next(ui + 1, nxt);
        const char* nA = has_next ? (const char*)g.A + (size_t)nxt.pm * tstep + kbase : cA; const char* nB = has_next ? (const char*)g.Bt + (size_t)nxt.pn * tstep + kbase : cB;
        for (int t = 0; t < nt; t += 2) {
            const bool last = (t == nt - 2);
            const char* a1 = cA + (long)(t + 1) * kstep;
            const char* a2 = last ? nA : cA + (long)(t + 2) * kstep; const char* b2 = last ? nB : cB + (long)(t + 2) * kstep;
            const char* a3 = a2 + kstep; const char* b3 = b2 + kstep;
            if (last && has_next) S.a_ready(nxt);
            if constexpr (SP2) {
            PG8_LDB(B0, 0, 0); PG8_LDB(B1, 0, 1); PG8_SCHED; PG8_LDA(At, 0, 0); PG8_STAGE(PG8_SA(1, 1), a1 + hstep, voffA);
            PG8_WAIT_V(8); PG8_WAIT_L(0); PG8_BAR; PG8_MMA(0, 0, At, B0); PG8_MMA(0, 1, At, B1); PG8_BAR; PG8_SCHED;
            PG8_LDA(At, 0, 1); PG8_STAGE(PG8_SB(0, 0), b2, voffB); PG8_STAGE(PG8_SB(0, 1), b2 + hstep, voffB); PG8_STAGE(PG8_SA(0, 0), a2, voffA);
            PG8_WAIT_V(8); PG8_WAIT_L(0); PG8_BAR; PG8_MMA(1, 0, At, B0); PG8_MMA(1, 1, At, B1); PG8_BAR; PG8_SCHED;
            PG8_LDB(B0, 1, 0); PG8_LDB(B1, 1, 1); PG8_SCHED; PG8_LDA(At, 1, 0); PG8_STAGE(PG8_SA(0, 1), a2 + hstep, voffA);
            PG8_WAIT_V(8); PG8_WAIT_L(0); PG8_BAR; PG8_MMA(0, 0, At, B0); PG8_MMA(0, 1, At, B1); PG8_BAR; PG8_SCHED;
            PG8_LDA(At, 1, 1); PG8_STAGE(PG8_SB(1, 0), b3, voffB); PG8_STAGE(PG8_SB(1, 1), b3 + hstep, voffB); PG8_STAGE(PG8_SA(1, 0), a3, voffA);
            PG8_WAIT_V(8); PG8_WAIT_L(0); PG8_BAR; PG8_MMA(1, 0, At, B0); PG8_MMA(1, 1, At, B1); PG8_BAR; PG8_SCHED;
            } else {
            PG8_LDB(B0, 0, 0); PG8_SCHED; PG8_LDA(At, 0, 0); PG8_STAGE(PG8_SA(1, 1), a1 + hstep, voffA);
            PG8_WAIT_L(8); PG8_BAR; PG8_WAIT_L(0); PG8_MMA(0, 0, At, B0); PG8_BAR; PG8_SCHED;
            PG8_LDB(B1, 0, 1); PG8_STAGE(PG8_SB(0, 0), b2, voffB);
            PG8_BAR; PG8_WAIT_L(0); PG8_MMA(0, 1, At, B1); PG8_BAR;
            PG8_LDA(At, 0, 1); PG8_STAGE(PG8_SA(0, 0), a2, voffA);
            PG8_BAR; PG8_WAIT_L(0); PG8_MMA(1, 0, At, B0); PG8_BAR; PG8_SCHED;
            PG8_STAGE(PG8_SB(0, 1), b2 + hstep, voffB);
            PG8_WAIT_V(6); PG8_BAR; PG8_MMA(1, 1, At, B1); PG8_BAR;
            PG8_LDB(B0, 1, 0); PG8_SCHED; PG8_LDA(At, 1, 0); PG8_STAGE(PG8_SA(0, 1), a2 + hstep, voffA);
            PG8_WAIT_L(8); PG8_BAR; PG8_WAIT_L(0); PG8_MMA(0, 0, At, B0); PG8_BAR; PG8_SCHED;
            PG8_LDB(B1, 1, 1); PG8_STAGE(PG8_SB(1, 0), b3, voffB);
            PG8_BAR; PG8_WAIT_L(0); PG8_MMA(0, 1, At, B1); PG8_BAR;
            PG8_LDA(At, 1, 1); PG8_STAGE(PG8_SA(1, 0), a3, voffA);
            PG8_BAR; PG8_WAIT_L(0); PG8_MMA(1, 0, At, B0); PG8_BAR; PG8_SCHED;
            PG8_STAGE(PG8_SB(1, 1), b3 + hstep, voffB);
            PG8_WAIT_V(6); PG8_BAR; PG8_MMA(1, 1, At, B1); PG8_BAR;
            }
        }
        if constexpr (ALIGN_EPI) { if (wr == 0) PG8_BAR; }
        if constexpr (!Epi::AFTER_DRAIN) { E(acc, cur, wr, wc, fr, fq, pre); S.done(cur); }
        if (!has_next) break;
        cur = nxt; cA = nA; cB = nB; ++ui; E.prefetch(cur, wr, fr, pre); E.init_acc(acc, cur, wr, wc, fr, fq); E.settle(acc);
        if constexpr (ALIGN_EPI) { if (wr == 1) PG8_BAR; }
    }
    PG8_WAIT_V(0);
    if constexpr (!ALIGN_EPI) { if (wr == 0) PG8_BAR; }
    PG8_BAR;
    if constexpr (Epi::AFTER_DRAIN) { E.fused(acc, cur, wr, wc, fr, fq, lds, wid, lane); S.done(cur); }
#undef PG8_SA
#undef PG8_SB
#undef PG8_STAGE
#undef PG8_LDA
#undef PG8_LDB
#undef PG8_MMA
#undef PG8_WAIT_V
#undef PG8_WAIT_L
#undef PG8_BAR
#undef PG8_SCHED
}
}
using pg8::bf16_t; using pg8::bf16x8; using pg8::f32x4; using pg8::u32x4; using pg8::Unit;
#define LAS __attribute__((address_space(3)))
typedef float f32x16 __attribute__((ext_vector_type(16)));
typedef float f32x2_t __attribute__((ext_vector_type(2)));
typedef __bf16 bf16x2_t __attribute__((ext_vector_type(2)));
typedef short s16x4 __attribute__((ext_vector_type(4)));
typedef short v4i16_t __attribute__((ext_vector_type(4)));
typedef unsigned u32x2 __attribute__((ext_vector_type(2)));

constexpr int DM = 1024, NB = 4, SEQ = 4096, MTOK = NB * SEQ, DEPTH = 2, DFF = 2816, DIN = 2816, MEML = 256, MMEM = NB * MEML;
constexpr float LOG2E = 1.4426950408889634f;
constexpr int LDS_BYTES = 147456;

__device__ __forceinline__ unsigned cvtpk(float lo, float hi) { f32x2_t v = {lo, hi}; bf16x2_t b = __builtin_convertvector(v, bf16x2_t); return __builtin_bit_cast(unsigned, b); }
__device__ __forceinline__ float bflo(unsigned u) { return __builtin_bit_cast(float, u << 16); }
__device__ __forceinline__ float bfhi(unsigned u) { return __builtin_bit_cast(float, u & 0xffff0000u); }
__device__ __forceinline__ float wave_sum(float v) { v += __shfl_xor(v, 32); v += __shfl_xor(v, 16); v += __shfl_xor(v, 8); v += __shfl_xor(v, 4); v += __shfl_xor(v, 2); v += __shfl_xor(v, 1); return v; }
__device__ __forceinline__ float silu_f(float g) { return g * __builtin_amdgcn_rcpf(1.f + __builtin_amdgcn_exp2f(g * -1.4426950408889634f)); }

struct OffOrder {
    int nM, nN, nwg, G, c;
    __device__ void init(int M, int N, int G_, int c_, int off) { nM = M / 256; nN = N / 256; nwg = nM * nN; G = G_; c = c_ - off; if (c < 0) c += G_; }
    __device__ bool next(int i, Unit& u) const {
        const long L = (long)i * G + c; if (L >= nwg) return false;
        int wgid = (int)L; { const int q = nwg / 8, r = nwg % 8, xcd = wgid % 8, off = wgid / 8; wgid = (xcd < r ? xcd * (q + 1) : r * (q + 1) + (xcd - r) * q) + off; }
        const int nig = 8 * nN, gid = wgid / nig, fm = gid * 8, gsz = (nM - fm) < 8 ? (nM - fm) : 8;
        u.pm = fm + ((wgid % nig) % gsz); u.pn = (wgid % nig) / gsz; return true;
    }
    __device__ __forceinline__ void a_ready(const Unit&) const {}
    __device__ __forceinline__ void done(const Unit&) const {}
};

struct EpiStore {
    static constexpr bool PERM = true, AFTER_DRAIN = false;
    bf16_t* O; const float* RS; int ldc; int pad_;
    __device__ __forceinline__ void prefetch(const Unit& u, int wr, int fr, float (&pre)[8]) const {
        const int row0 = u.pm * 256 + wr * 64 + fr;
#pragma unroll
        for (int i = 0; i < 8; ++i) pre[i] = RS ? RS[row0 + (i >> 2) * 128 + (i & 3) * 16] : 0.f;
    }
    __device__ __forceinline__ void init_acc(f32x4 (&acc)[2][2][4][2], const Unit&, int, int, int, int) const {
#pragma unroll
        for (int a = 0; a < 2; ++a)
#pragma unroll
            for (int b = 0; b < 2; ++b)
#pragma unroll
                for (int m = 0; m < 4; ++m)
#pragma unroll
                    for (int n = 0; n < 2; ++n) acc[a][b][m][n] = (f32x4){0.f, 0.f, 0.f, 0.f};
    }
    __device__ __forceinline__ void settle(f32x4 (&)[2][2][4][2]) const {}
    __device__ __forceinline__ void operator()(const f32x4 (&acc)[2][2][4][2], const Unit& u, int wr, int wc, int fr, int fq, const float (&pre)[8]) const {
        const int row0 = u.pm * 256 + wr * 64 + fr, col0 = u.pn * 256 + wc * 32 + 8 * fq;
#pragma unroll
        for (int ai = 0; ai < 2; ++ai)
#pragma unroll
            for (int m = 0; m < 4; ++m) { bf16_t* rowp = O + (size_t)(row0 + ai * 128 + m * 16) * ldc + col0; const float r = RS ? rsqrtf(pre[ai * 4 + m] * (1.f / 1024.f) + 1e-6f) : 1.f;
#pragma unroll
                for (int bj = 0; bj < 2; ++bj) { const f32x4 v0 = acc[ai][bj][m][0] * r, v1 = acc[ai][bj][m][1] * r; u32x4 w; w.x = cvtpk(v0[0], v0[1]); w.y = cvtpk(v0[2], v0[3]); w.z = cvtpk(v1[0], v1[1]); w.w = cvtpk(v1[2], v1[3]);
                    *(u32x4*)(rowp + bj * 128) = w; } }
    }
};
struct EpiSwiglu {
    static constexpr bool PERM = true, AFTER_DRAIN = false;
    bf16_t* O; const float* RS; int ldc; int pad_;
    __device__ __forceinline__ void prefetch(const Unit& u, int wr, int fr, float (&pre)[8]) const {
        const int row0 = u.pm * 256 + wr * 64 + fr;
#pragma unroll
        for (int i = 0; i < 8; ++i) pre[i] = RS[row0 + (i >> 2) * 128 + (i & 3) * 16];
    }
    __device__ __forceinline__ void init_acc(f32x4 (&acc)[2][2][4][2], const Unit&, int, int, int, int) const {
#pragma unroll
        for (int a = 0; a < 2; ++a)
#pragma unroll
            for (int b = 0; b < 2; ++b)
#pragma unroll
                for (int m = 0; m < 4; ++m)
#pragma unroll
                    for (int n = 0; n < 2; ++n) acc[a][b][m][n] = (f32x4){0.f, 0.f, 0.f, 0.f};
    }
    __device__ __forceinline__ void settle(f32x4 (&)[2][2][4][2]) const {}
    __device__ __forceinline__ void operator()(const f32x4 (&acc)[2][2][4][2], const Unit& u, int wr, int wc, int fr, int fq, const float (&pre)[8]) const {
        const int row0 = u.pm * 256 + wr * 64 + fr, col0 = u.pn * 128 + wc * 32 + 8 * fq;
#pragma unroll
        for (int ai = 0; ai < 2; ++ai)
#pragma unroll
            for (int m = 0; m < 4; ++m) { bf16_t* rowp = O + (size_t)(row0 + ai * 128 + m * 16) * ldc + col0; const float r = rsqrtf(pre[ai * 4 + m] * (1.f / 1024.f) + 1e-6f);
                const float k1 = r * -1.4426950408889634f, rr = r * r; u32x4 w;
#pragma unroll
                for (int n = 0; n < 2; ++n) { const f32x4 g = acc[ai][0][m][n], uu = acc[ai][1][m][n]; const f32x4 t = g * uu, x = g * k1; f32x4 d;
                    d[0] = __builtin_amdgcn_exp2f(x[0]); d[1] = __builtin_amdgcn_exp2f(x[1]); d[2] = __builtin_amdgcn_exp2f(x[2]); d[3] = __builtin_amdgcn_exp2f(x[3]);
                    d = d + 1.0f;
                    d[0] = __builtin_amdgcn_rcpf(d[0]); d[1] = __builtin_amdgcn_rcpf(d[1]); d[2] = __builtin_amdgcn_rcpf(d[2]); d[3] = __builtin_amdgcn_rcpf(d[3]);
                    const f32x4 o = (t * d) * rr;
                    if (n == 0) { w.x = cvtpk(o[0], o[1]); w.y = cvtpk(o[2], o[3]); } else { w.z = cvtpk(o[0], o[1]); w.w = cvtpk(o[2], o[3]); } }
                *(u32x4*)rowp = w; }
    }
};
struct HiLoIn {
    const float* Xin32; const bf16_t* HiIn; const bf16_t* LoIn;
    __device__ __forceinline__ void init(f32x4 (&acc)[2][2][4][2], const Unit& u, int wr, int wc, int fr, int fq) const {
        const int row0 = u.pm * 256 + wr * 64 + fr, col0 = u.pn * 256 + wc * 32 + 8 * fq;
#pragma unroll
        for (int ai = 0; ai < 2; ++ai)
#pragma unroll
            for (int m = 0; m < 4; ++m)
#pragma unroll
                for (int bj = 0; bj < 2; ++bj) { const size_t p = (size_t)(row0 + ai * 128 + m * 16) * DM + col0 + bj * 128;
                    if (Xin32) { acc[ai][bj][m][0] = *(const f32x4*)(Xin32 + p); acc[ai][bj][m][1] = *(const f32x4*)(Xin32 + p + 4); }
                    else { acc[ai][bj][m][0] = __builtin_bit_cast(f32x4, *(const u32x4*)(HiIn + p)); acc[ai][bj][m][1] = __builtin_bit_cast(f32x4, *(const u32x4*)(LoIn + p)); } }
    }
    __device__ __forceinline__ void settle(f32x4 (&acc)[2][2][4][2]) const {
#pragma unroll
        for (int a = 0; a < 2; ++a)
#pragma unroll
            for (int b = 0; b < 2; ++b)
#pragma unroll
                for (int m = 0; m < 4; ++m) {
                    asm volatile("" : "+v"(acc[a][b][m][0])); asm volatile("" : "+v"(acc[a][b][m][1]));
                    if (!Xin32) { const u32x4 h = __builtin_bit_cast(u32x4, acc[a][b][m][0]), l = __builtin_bit_cast(u32x4, acc[a][b][m][1]);
                        acc[a][b][m][0] = (f32x4){bflo(h.x) + bflo(l.x), bfhi(h.x) + bfhi(l.x), bflo(h.y) + bflo(l.y), bfhi(h.y) + bfhi(l.y)};
                        acc[a][b][m][1] = (f32x4){bflo(h.z) + bflo(l.z), bfhi(h.z) + bfhi(l.z), bflo(h.w) + bflo(l.w), bfhi(h.w) + bfhi(l.w)}; } }
    }
};
struct EpiResid {
    static constexpr bool PERM = true, AFTER_DRAIN = false;
    HiLoIn in; bf16_t* HiOut; bf16_t* LoOut; float* RS;
    __device__ __forceinline__ void prefetch(const Unit&, int, int, float (&)[8]) const {}
    __device__ __forceinline__ void init_acc(f32x4 (&acc)[2][2][4][2], const Unit& u, int wr, int wc, int fr, int fq) const { in.init(acc, u, wr, wc, fr, fq); }
    __device__ __forceinline__ void settle(f32x4 (&acc)[2][2][4][2]) const { in.settle(acc); }
    __device__ __forceinline__ void operator()(const f32x4 (&acc)[2][2][4][2], const Unit& u, int wr, int wc, int fr, int fq, const float (&)[8]) const {
        const int row0 = u.pm * 256 + wr * 64 + fr, col0 = u.pn * 256 + wc * 32 + 8 * fq;
        float ssv[2][4];
#pragma unroll
        for (int ai = 0; ai < 2; ++ai)
#pragma unroll
            for (int m = 0; m < 4; ++m) { const int row = row0 + ai * 128 + m * 16; float ss = 0.f;
#pragma unroll
                for (int bj = 0; bj < 2; ++bj) { const size_t p = (size_t)row * DM + col0 + bj * 128; const f32x4 a = acc[ai][bj][m][0], b = acc[ai][bj][m][1];
                    u32x4 w; w.x = cvtpk(a[0], a[1]); w.y = cvtpk(a[2], a[3]); w.z = cvtpk(b[0], b[1]); w.w = cvtpk(b[2], b[3]); *(u32x4*)(HiOut + p) = w;
                    u32x4 v; v.x = cvtpk(a[0] - bflo(w.x), a[1] - bfhi(w.x)); v.y = cvtpk(a[2] - bflo(w.y), a[3] - bfhi(w.y)); v.z = cvtpk(b[0] - bflo(w.z), b[1] - bfhi(w.z)); v.w = cvtpk(b[2] - bflo(w.w), b[3] - bfhi(w.w));
                    *(u32x4*)(LoOut + p) = v;
                    ss += (a[0] * a[0] + a[1] * a[1]) + (a[2] * a[2] + a[3] * a[3]) + (b[0] * b[0] + b[1] * b[1]) + (b[2] * b[2] + b[3] * b[3]); }
                ss += __shfl_xor(ss, 16); ss += __shfl_xor(ss, 32); ssv[ai][m] = ss; }
#pragma unroll
        for (int ai = 0; ai < 2; ++ai) { const float v = fq == 0 ? ssv[ai][0] : fq == 1 ? ssv[ai][1] : fq == 2 ? ssv[ai][2] : ssv[ai][3];
            (void)__hip_atomic_fetch_add(RS + row0 + ai * 128 + fq * 16, v, __ATOMIC_RELAXED, __HIP_MEMORY_SCOPE_AGENT); }
    }
};
struct EpiFinal {
    static constexpr bool PERM = true, AFTER_DRAIN = false;
    HiLoIn in; float* Out; float* RS; const float* g; unsigned* cnt;
    __device__ __forceinline__ void prefetch(const Unit&, int, int, float (&)[8]) const {}
    __device__ __forceinline__ void init_acc(f32x4 (&acc)[2][2][4][2], const Unit& u, int wr, int wc, int fr, int fq) const { in.init(acc, u, wr, wc, fr, fq); }
    __device__ __forceinline__ void settle(f32x4 (&acc)[2][2][4][2]) const { in.settle(acc); }
    __device__ __forceinline__ void operator()(const f32x4 (&acc_)[2][2][4][2], const Unit& u, int wr, int wc, int fr, int fq, const float (&)[8]) const {
        f32x4 (&acc)[2][2][4][2] = const_cast<f32x4 (&)[2][2][4][2]>(acc_);
        const int row0 = u.pm * 256 + wr * 64 + fr, col0 = u.pn * 256 + wc * 32 + 8 * fq;
        float ssv[2][4];
#pragma unroll
        for (int ai = 0; ai < 2; ++ai)
#pragma unroll
            for (int m = 0; m < 4; ++m) { const int row = row0 + ai * 128 + m * 16; const size_t ro = (size_t)row * DM + col0; float ss = 0.f;
#pragma unroll
                for (int bj = 0; bj < 2; ++bj) { const size_t p = ro + bj * 128;
                    const f32x4 a = acc[ai][bj][m][0], b = acc[ai][bj][m][1];
                    ss += (a[0] * a[0] + a[1] * a[1]) + (a[2] * a[2] + a[3] * a[3]) + (b[0] * b[0] + b[1] * b[1]) + (b[2] * b[2] + b[3] * b[3]); }
                ss += __shfl_xor(ss, 16); ss += __shfl_xor(ss, 32); ssv[ai][m] = ss; }
#pragma unroll
        for (int ai = 0; ai < 2; ++ai) { const float v = fq == 0 ? ssv[ai][0] : fq == 1 ? ssv[ai][1] : fq == 2 ? ssv[ai][2] : ssv[ai][3];
            (void)__hip_atomic_fetch_add(RS + row0 + ai * 128 + fq * 16, v, __ATOMIC_RELAXED, __HIP_MEMORY_SCOPE_AGENT); }
        asm volatile("s_waitcnt vmcnt(0)" ::: "memory");
        __syncthreads();
        if (tid_opq() == 0) {
            (void)__hip_atomic_fetch_add(cnt + u.pm * 16, 1u, __ATOMIC_RELEASE, __HIP_MEMORY_SCOPE_AGENT);
            unsigned spins = 0;
            while (__hip_atomic_load(cnt + u.pm * 16, __ATOMIC_ACQUIRE, __HIP_MEMORY_SCOPE_AGENT) < 4u && ++spins < (1u << 22)) __builtin_amdgcn_s_sleep(1);
        }
        __syncthreads();
        f32x4 gv[2][2];
#pragma unroll
        for (int bj = 0; bj < 2; ++bj) { gv[bj][0] = *(const f32x4*)(g + col0 + bj * 128); gv[bj][1] = *(const f32x4*)(g + col0 + bj * 128 + 4); }
#pragma unroll
        for (int ai = 0; ai < 2; ++ai)
#pragma unroll
            for (int m = 0; m < 4; ++m) { const int row = row0 + ai * 128 + m * 16; const size_t ro = (size_t)row * DM + col0;
                const float r = rsqrtf(__hip_atomic_load(RS + row, __ATOMIC_RELAXED, __HIP_MEMORY_SCOPE_AGENT) * (1.f / 1024.f) + 1e-6f);
#pragma unroll
                for (int bj = 0; bj < 2; ++bj) { const size_t p = ro + bj * 128;
                    *(f32x4*)(Out + p) = acc[ai][bj][m][0] * r * gv[bj][0]; *(f32x4*)(Out + p + 4) = acc[ai][bj][m][1] * r * gv[bj][1]; } }
    }
};

template <class Epi>
__device__ __forceinline__ void run_gemm(LAS unsigned char* lds, const bf16_t* A, const bf16_t* Bt, int M, int N, int K, const Epi E, int off = 0, int krev = 0) {
    pg8::Gemm g; g.A = A; g.Bt = Bt; g.M = M; g.N = N; g.K = K; g.krev = krev;
    OffOrder S; S.init(M, N, (int)gridDim.x, bid_opq(), off);
    pg8::gemm_phase<Epi, OffOrder, true, true>(lds, g, S, E);
}

__device__ void cvt_w(LAS unsigned char* lds, const float* __restrict__ W, int K, int N, bf16_t* __restrict__ Bt, int mode, const float* __restrict__ gain = nullptr, int first = 0, int nblk = 0, float mul = 1.f) {
    LAS float* tile = (LAS float*)lds;
    const int tid = tid_opq(), ntn = N / 128, nt = (K / 64) * ntn;
    const int lk = tid >> 5, ln4 = (tid & 31) * 4;
    f32x4 v[4];
    const int tstride = nblk ? nblk : (int)gridDim.x;
    int t = bid_opq() - first;
    if (t < nt) { const int k0 = (t / ntn) * 64, n0 = (t % ntn) * 128;
#pragma unroll
        for (int i = 0; i < 4; ++i) v[i] = *(const f32x4*)(W + (size_t)(k0 + lk + 16 * i) * N + n0 + ln4); }
    for (; t < nt; t += tstride) {
        const int k0 = (t / ntn) * 64, n0 = (t % ntn) * 128;
        __syncthreads();
#pragma unroll
        for (int i = 0; i < 4; ++i) { const int kk = lk + 16 * i; f32x4 x = v[i] * mul; if (gain) x *= gain[k0 + kk];
            tile[kk * 129 + ln4] = x[0]; tile[kk * 129 + ln4 + 1] = x[1]; tile[kk * 129 + ln4 + 2] = x[2]; tile[kk * 129 + ln4 + 3] = x[3]; }
        const int tn = t + tstride;
        if (tn < nt) { const int k1 = (tn / ntn) * 64, n1 = (tn % ntn) * 128;
#pragma unroll
            for (int i = 0; i < 4; ++i) v[i] = *(const f32x4*)(W + (size_t)(k1 + lk + 16 * i) * N + n1 + ln4); }
        __syncthreads();
#pragma unroll
        for (int h = 0; h < 2; ++h) {
            const int n = (tid >> 3) + 64 * h, k8 = (tid & 7) * 8; float f[8];
#pragma unroll
            for (int j = 0; j < 8; ++j) f[j] = tile[(k8 + j) * 129 + n];
            const int nn = n0 + n; int row = nn; if (mode) row = (nn >> 7) * 256 + (nn & 127) + (mode == 2 ? 128 : 0);
            u32x4 w; w.x = cvtpk(f[0], f[1]); w.y = cvtpk(f[2], f[3]); w.z = cvtpk(f[4], f[5]); w.w = cvtpk(f[6], f[7]);
            *(u32x4*)(Bt + (size_t)row * K + k0 + k8) = w;
        }
    }
}

__device__ void norm_rows_bf16(const float* __restrict__ X, const float* __restrict__ g, bf16_t* __restrict__ H, int rows) {
    const int lane = tid_opq() & 63, gw = bid_opq() * 8 + (tid_opq() >> 6), stride = gridDim.x * 8;
    for (int r = gw; r < rows; r += stride) {
        const f32x4* xr = (const f32x4*)(X + (size_t)r * DM); f32x4 v[4]; float ss = 0.f;
#pragma unroll
        for (int i = 0; i < 4; ++i) { v[i] = xr[lane + 64 * i]; ss += v[i][0] * v[i][0] + v[i][1] * v[i][1] + v[i][2] * v[i][2] + v[i][3] * v[i][3]; }
        ss = wave_sum(ss); const float rstd = rsqrtf(ss * (1.f / DM) + 1e-6f);
#pragma unroll
        for (int i = 0; i < 4; ++i) { const f32x4 gg = ((const f32x4*)g)[lane + 64 * i]; u32x2 w; w.x = cvtpk(v[i][0] * rstd * gg[0], v[i][1] * rstd * gg[1]); w.y = cvtpk(v[i][2] * rstd * gg[2], v[i][3] * rstd * gg[3]);
            *(u32x2*)(H + (size_t)r * DM + (lane + 64 * i) * 4) = w; }
    }
}
__device__ void prep_rows(const float* __restrict__ X, bf16_t* __restrict__ XB, float* __restrict__ PS, int rows) {
    const int lane = tid_opq() & 63, gw = bid_opq() * 8 + (tid_opq() >> 6), stride = gridDim.x * 8;
    for (int r = gw; r < rows; r += stride) {
        const f32x4* xr = (const f32x4*)(X + (size_t)r * DM); float ss = 0.f;
#pragma unroll
        for (int i = 0; i < 4; ++i) { const f32x4 v = xr[lane + 64 * i]; ss += v[0] * v[0] + v[1] * v[1] + v[2] * v[2] + v[3] * v[3];
            u32x2 w; w.x = cvtpk(v[0], v[1]); w.y = cvtpk(v[2], v[3]); *(u32x2*)(XB + (size_t)r * DM + (lane + 64 * i) * 4) = w; }
        ss = wave_sum(ss);
        if (lane == 0) PS[r] = ss;
    }
}
__device__ void final_rows(const bf16_t* __restrict__ Hi, const bf16_t* __restrict__ Lo, float* __restrict__ Out, const float* __restrict__ PS, const float* __restrict__ g, int rows) {
    const int lane = tid_opq() & 63, gw = bid_opq() * 8 + (tid_opq() >> 6), stride = gridDim.x * 8;
    for (int r = gw; r < rows; r += stride) {
        const float rstd = rsqrtf(PS[r] * (1.f / DM) + 1e-6f);
#pragma unroll
        for (int i = 0; i < 2; ++i) { const size_t p = (size_t)r * DM + (lane + 64 * i) * 8; const u32x4 h = *(const u32x4*)(Hi + p), l = *(const u32x4*)(Lo + p);
            const f32x4 g0 = *(const f32x4*)(g + (lane + 64 * i) * 8), g1 = *(const f32x4*)(g + (lane + 64 * i) * 8 + 4);
            *(f32x4*)(Out + p) = (f32x4){bflo(h.x) + bflo(l.x), bfhi(h.x) + bfhi(l.x), bflo(h.y) + bflo(l.y), bfhi(h.y) + bfhi(l.y)} * rstd * g0;
            *(f32x4*)(Out + p + 4) = (f32x4){bflo(h.z) + bflo(l.z), bfhi(h.z) + bfhi(l.z), bflo(h.w) + bflo(l.w), bfhi(h.w) + bfhi(l.w)} * rstd * g1; }
    }
}
__device__ void norm_rows_f32(const float* X, const float* __restrict__ g, float* O, int rows) {
    const int lane = tid_opq() & 63, gw = bid_opq() * 8 + (tid_opq() >> 6), stride = gridDim.x * 8;
    for (int r = gw; r < rows; r += stride) {
        const f32x4* xr = (const f32x4*)(X + (size_t)r * DM); f32x4 v[4]; float ss = 0.f;
#pragma unroll
        for (int i = 0; i < 4; ++i) { v[i] = xr[lane + 64 * i]; ss += v[i][0] * v[i][0] + v[i][1] * v[i][1] + v[i][2] * v[i][2] + v[i][3] * v[i][3]; }
        ss = wave_sum(ss); const float rstd = rsqrtf(ss * (1.f / DM) + 1e-6f);
#pragma unroll
        for (int i = 0; i < 4; ++i) { const f32x4 gg = ((const f32x4*)g)[lane + 64 * i]; ((f32x4*)(O + (size_t)r * DM))[lane + 64 * i] = v[i] * rstd * gg; }
    }
}

__device__ __forceinline__ s16x4 vtr(LAS const unsigned char* p) { return __builtin_bit_cast(s16x4, __builtin_amdgcn_ds_read_tr16_b64_v4i16((LAS v4i16_t*)p)); }

template <bool DIFF>
__device__ __forceinline__ void attn_unit(LAS unsigned char* lds, const bf16_t* __restrict__ Qp, int qpitch, const bf16_t* __restrict__ Kp, const bf16_t* __restrict__ Vp, int kvpitch,
                                          int nkt, int qpos0, float sc2, float sl2, float lam, bf16_t* __restrict__ Op, int opitch, const float* __restrict__ subg, float oscale) {
    constexpr int ROWB = DIFF ? 256 : 512, CPR = ROWB / 16, KSTR = ROWB + 16, VSTR = ROWB + 64, KBY = 64 * KSTR, VBY = 64 * VSTR, STAGE = KBY + VBY, NCH = CPR / 8, NKS = DIFF ? 4 : 16;
    const int tid = tid_opq(), wid = __builtin_amdgcn_readfirstlane(tid >> 6), lane = tid & 63, c = wid >> 2, qr = (wid & 3) * 32, l32 = lane & 31, hi = lane >> 5;
    constexpr int QSTR = 528, QOFF = STAGE;
    bf16x8 qf[DIFF ? NKS : 1];
    if (DIFF) { const bf16_t* qrow = Qp + (size_t)(qr + l32) * qpitch + c * 64 + hi * 8;
#pragma unroll
      for (int ks = 0; ks < (DIFF ? NKS : 1); ++ks) qf[ks] = *(const bf16x8*)(qrow + ks * 16); }
    f32x16 o[4];
#pragma unroll
    for (int i = 0; i < 4; ++i)
#pragma unroll
        for (int r = 0; r < 16; ++r) o[i][r] = 0.f;
    float m_run = -INFINITY, l_run = 0.f;
    u32x4 kreg[NCH], vreg[NCH];
    const int srow = tid / CPR, sch = tid % CPR;
    const size_t goff = (size_t)srow * kvpitch + sch * 8;
    const int loffk = srow * KSTR + sch * 16, loffv = KBY + srow * VSTR + sch * 16;
#define ATT_GLOAD(kt) do { _Pragma("unroll") for (int i = 0; i < NCH; ++i) { const size_t go = goff + (size_t)((kt) * 64 + i * (512 / CPR)) * kvpitch; \
        kreg[i] = *(const u32x4*)(Kp + go); vreg[i] = *(const u32x4*)(Vp + go); } } while (0)
#define ATT_LSTORE(buf) do { LAS unsigned char* bb = lds + (buf) * STAGE; _Pragma("unroll") for (int i = 0; i < NCH; ++i) { \
        *(LAS u32x4*)(bb + loffk + i * (512 / CPR) * KSTR) = kreg[i]; *(LAS u32x4*)(bb + loffv + i * (512 / CPR) * VSTR) = vreg[i]; } } while (0)
    constexpr int DSTG = 32768;
    const int dch = (lane & 15) ^ ((((lane >> 4) & 3) << 2) | (wid & 3));
#define ATT_DMA(kt, st) do { _Pragma("unroll") for (int i = 0; i < 2; ++i) { const int j = wid + 8 * i; \
        const size_t go = (size_t)((kt) * 64 + j * 4 + (lane >> 4)) * kvpitch + dch * 8; \
        __builtin_amdgcn_global_load_lds((const unsigned*)(Kp + go), (LAS unsigned*)(lds + (st) * DSTG + j * 1024), 16, 0, 0); \
        __builtin_amdgcn_global_load_lds((const unsigned*)(Vp + go), (LAS unsigned*)(lds + (st) * DSTG + 16384 + j * 1024), 16, 0, 0); } } while (0)
    __syncthreads();
    if (DIFF) { ATT_DMA(nkt - 1, 0); }
    else { ATT_GLOAD(0);
#pragma unroll
        for (int i = 0; i < 8; ++i) { const int id = tid + 512 * i, row = id >> 5, ch = id & 31;
            *(LAS u32x4*)(lds + QOFF + row * QSTR + ch * 16) = *(const u32x4*)(Qp + (size_t)row * qpitch + ch * 8); }
    }
    const int wrow = qpos0 + qr;
    f32x16 biasv;
    { const float beta = DIFF ? sl2 / sc2 : 0.f;
#pragma unroll
      for (int r = 0; r < 16; ++r) biasv[r] = beta * (float)((r >> 2) * 8 + (r & 3) + hi * 4 - l32); }
    int it = 0;
#pragma unroll 1
    for (int kt = DIFF ? nkt - 1 : 0; DIFF ? (kt >= 0) : (kt < nkt); kt += DIFF ? -1 : 1, ++it) {
        if (DIFF) asm volatile("s_waitcnt vmcnt(0)" ::: "memory");
        __syncthreads();
        if (DIFF) { if (kt > 0) ATT_DMA(kt - 1, (it + 1) & 1); }
        else { ATT_LSTORE(0); if (kt + 1 < nkt) ATT_GLOAD(kt + 1); __syncthreads(); }
        const bool active = DIFF ? (64 * kt <= wrow) : true;
        if (active) {
            LAS const unsigned char* kb = DIFF ? lds + (it & 1) * DSTG : lds; LAS const unsigned char* vb = DIFF ? kb + 16384 : kb + KBY;
            LAS const unsigned char* qa = lds + QOFF + (qr + l32) * QSTR + hi * 16;
            f32x16 s0 = biasv, s1 = biasv;
            LAS const unsigned char* ka = kb + l32 * KSTR + (DIFF ? c * 128 : 0) + hi * 16;
#pragma unroll 1
            for (int kq = 0; kq < NKS; kq += 4) {
                bf16x8 ka0[4], ka1[4], qq[4];
#pragma unroll
                for (int j = 0; j < 4; ++j) {
                    if (DIFF) { const int ko = 256 * l32 + 16 * (((c << 3) + 2 * j + hi) ^ (((l32 & 3) << 2) | ((l32 >> 2) & 3)));
                        ka0[j] = *(LAS const bf16x8*)(kb + ko); ka1[j] = *(LAS const bf16x8*)(kb + 8192 + ko); }
                    else { ka0[j] = *(LAS const bf16x8*)(ka + (kq + j) * 32); ka1[j] = *(LAS const bf16x8*)(ka + 32 * KSTR + (kq + j) * 32); }
                    qq[j] = DIFF ? qf[DIFF ? j : 0] : *(LAS const bf16x8*)(qa + (kq + j) * 32); }
                __builtin_amdgcn_sched_barrier(0);
#pragma unroll
                for (int j = 0; j < 4; ++j) { s0 = __builtin_amdgcn_mfma_f32_32x32x16_bf16(ka0[j], qq[j], s0, 0, 0, 0); s1 = __builtin_amdgcn_mfma_f32_32x32x16_bf16(ka1[j], qq[j], s1, 0, 0, 0); }
            }
            float c0 = 0.f, c1 = 0.f;
            if (DIFF) {
                c0 = sl2 * (float)(64 * kt - wrow); c1 = sl2 * (float)(64 * kt + 32 - wrow);
                if (64 * kt + 64 > wrow) {
                    asm volatile("" ::: "memory");
                    const int irel = wrow + l32 - 64 * kt - hi * 4;
#pragma unroll
                    for (int r = 0; r < 16; ++r) { const int cr = (r >> 2) * 8 + (r & 3); if (cr > irel) s0[r] = -INFINITY; if (cr + 32 > irel) s1[r] = -INFINITY; }
                }
            }
            LAS const unsigned char* va = vb + (hi * 4 + ((lane & 15) >> 2)) * VSTR + (DIFF ? 0 : c * 256) + (((lane >> 4) & 1) * 16 + 4 * (lane & 3)) * 2;
            bf16x8 fa[4], fb[4];
            const int vq = (lane & 15) >> 2, vp = lane & 3, vg1 = (lane >> 4) & 1;
            const int vs0 = 256 * (hi * 4 + vq) + 16 * ((2 * vg1 + (vp >> 1)) ^ hi) + 8 * (vp & 1), vs1 = 256 * (hi * 4 + 8 + vq) + 16 * ((2 * vg1 + (vp >> 1)) ^ (hi + 2)) + 8 * (vp & 1);
#define ATT_LOADG(F, dvb) do { _Pragma("unroll") for (int j = 0; j < 4; ++j) { LAS const unsigned char* pp = va + (j * 16) * VSTR + (dvb) * 64; \
                LAS const unsigned char* p0 = DIFF ? vb + vs0 + 64 * ((dvb) ^ vq) + j * 4096 : pp; LAS const unsigned char* p1 = DIFF ? vb + vs1 + 64 * ((dvb) ^ vq) + j * 4096 : pp + 8 * VSTR; \
                const s16x4 lo = vtr(p0), h4 = vtr(p1); bf16x8 t_; t_[0] = lo[0]; t_[1] = lo[1]; t_[2] = lo[2]; t_[3] = lo[3]; t_[4] = h4[0]; t_[5] = h4[1]; t_[6] = h4[2]; t_[7] = h4[3]; F[j] = t_; } } while (0)
#define ATT_MMAG(F, dvb) do { _Pragma("unroll") for (int j = 0; j < 4; ++j) o[dvb] = __builtin_amdgcn_mfma_f32_32x32x16_bf16(F[j], pb[j >> 1][j & 1], o[dvb], 0, 0, 0); } while (0)
            float mx0 = s0[0], mx1 = s1[0];
#pragma unroll
            for (int r = 1; r < 16; r += 2) { mx0 = fmaxf(fmaxf(mx0, s0[r]), s0[r + 1 < 16 ? r + 1 : r]); mx1 = fmaxf(fmaxf(mx1, s1[r]), s1[r + 1 < 16 ? r + 1 : r]); }
            float mx = fmaxf(__builtin_fmaf(mx0, sc2, c0), __builtin_fmaf(mx1, sc2, c1));
            mx = fmaxf(mx, __shfl_xor(mx, 32));
            __builtin_amdgcn_sched_barrier(0);
            ATT_LOADG(fa, 0); ATT_LOADG(fb, 1);
            __builtin_amdgcn_sched_barrier(0);
            if (__builtin_amdgcn_ballot_w64(mx > m_run) != 0ull) {
                const float mnew = fmaxf(m_run, mx), alpha = __builtin_amdgcn_exp2f(m_run - mnew); m_run = mnew; l_run *= alpha;
#pragma unroll
                for (int i = 0; i < 4; ++i)
#pragma unroll
                    for (int r = 0; r < 16; ++r) o[i][r] *= alpha;
            }
            const float d0 = c0 - m_run, d1 = c1 - m_run;
            float rs0 = 0.f, rs1 = 0.f;
#pragma unroll
            for (int r = 0; r < 16; ++r) { s0[r] = __builtin_amdgcn_exp2f(__builtin_fmaf(s0[r], sc2, d0)); s1[r] = __builtin_amdgcn_exp2f(__builtin_fmaf(s1[r], sc2, d1)); rs0 += s0[r]; rs1 += s1[r]; }
            l_run += rs0 + rs1;
            bf16x8 pb[2][2];
#pragma unroll
            for (int g = 0; g < 2; ++g) {
                u32x4 w0, w1;
                w0.x = cvtpk(s0[8 * g], s0[8 * g + 1]); w0.y = cvtpk(s0[8 * g + 2], s0[8 * g + 3]); w0.z = cvtpk(s0[8 * g + 4], s0[8 * g + 5]); w0.w = cvtpk(s0[8 * g + 6], s0[8 * g + 7]);
                w1.x = cvtpk(s1[8 * g], s1[8 * g + 1]); w1.y = cvtpk(s1[8 * g + 2], s1[8 * g + 3]); w1.z = cvtpk(s1[8 * g + 4], s1[8 * g + 5]); w1.w = cvtpk(s1[8 * g + 6], s1[8 * g + 7]);
                pb[0][g] = __builtin_bit_cast(bf16x8, w0); pb[1][g] = __builtin_bit_cast(bf16x8, w1);
            }
            __builtin_amdgcn_sched_barrier(0);
            ATT_MMAG(fa, 0); ATT_LOADG(fa, 2); __builtin_amdgcn_sched_barrier(0); ATT_MMAG(fb, 1); ATT_LOADG(fb, 3); __builtin_amdgcn_sched_barrier(0); ATT_MMAG(fa, 2); ATT_MMAG(fb, 3);
#undef ATT_LOADG
#undef ATT_MMAG
        }
    }
    l_run += __shfl_xor(l_run, 32);
#undef ATT_GLOAD
#undef ATT_LSTORE
#undef ATT_DMA
    const float inv = 1.f / l_run;
    if (DIFF) {
        __syncthreads();
        LAS float* ex = (LAS float*)lds + (wid & 3) * 4096;
        if (c == 1) { const float f = inv * lam;
#pragma unroll
            for (int i = 0; i < 4; ++i)
#pragma unroll
                for (int r = 0; r < 16; ++r) ex[(i * 16 + r) * 64 + lane] = o[i][r] * f; }
        __syncthreads();
        if (c == 0) {
            float ss = 0.f;
#pragma unroll
            for (int i = 0; i < 4; ++i)
#pragma unroll
                for (int r = 0; r < 16; ++r) { const float v = o[i][r] * inv - ex[(i * 16 + r) * 64 + lane]; o[i][r] = v; ss += v * v; }
            ss += __shfl_xor(ss, 32);
            const float rstd = rsqrtf(ss * (1.f / 128.f) + 1e-6f) * oscale;
            bf16_t* orow = Op + (size_t)(qr + l32) * opitch;
#pragma unroll
            for (int i = 0; i < 4; ++i)
#pragma unroll
                for (int r4 = 0; r4 < 4; ++r4) { const int dv = i * 32 + r4 * 8 + hi * 4; const f32x4 gg = *(const f32x4*)(subg + dv); u32x2 w;
                    w.x = cvtpk(o[i][4 * r4] * rstd * gg[0], o[i][4 * r4 + 1] * rstd * gg[1]); w.y = cvtpk(o[i][4 * r4 + 2] * rstd * gg[2], o[i][4 * r4 + 3] * rstd * gg[3]);
                    *(u32x2*)(orow + dv) = w; }
        }
    } else {
        bf16_t* orow = Op + (size_t)(qr + l32) * opitch + c * 128;
#pragma unroll
        for (int i = 0; i < 4; ++i)
#pragma unroll
            for (int r4 = 0; r4 < 4; ++r4) { const int dv = i * 32 + r4 * 8 + hi * 4; u32x2 w;
                w.x = cvtpk(o[i][4 * r4] * inv, o[i][4 * r4 + 1] * inv); w.y = cvtpk(o[i][4 * r4 + 2] * inv, o[i][4 * r4 + 3] * inv);
                *(u32x2*)(orow + dv) = w; }
    }
}

__device__ void conv_unit(LAS unsigned char* lds, const bf16_t* __restrict__ Z, bf16_t* __restrict__ MIX, int unit,
                          const float* __restrict__ ccw, const float* __restrict__ ccb, const float* __restrict__ lng, const float* __restrict__ lnb, const float* __restrict__ scw) {
    LAS float* ub = (LAS float*)lds;
    const int tid = tid_opq(), t0 = unit * 64, tpos0 = t0 & (SEQ - 1);
    __syncthreads();
#define SG(x) __builtin_amdgcn_rcpf(1.f + __builtin_amdgcn_exp2f((x) * -1.4426950408889634f))
    { u32x4 cav[6], cgv[6];
#pragma unroll
      for (int i = 0; i < 6; ++i) { const int id = tid + 512 * i, row = id >> 5, c8 = (id & 31) * 8; int gr = t0 - 30 + row; gr = gr < 0 ? 0 : gr; gr = gr > MTOK - 1 ? MTOK - 1 : gr;
          const bf16_t* zr = Z + (size_t)gr * DIN + 1536 + c8; cav[i] = *(const u32x4*)zr; cgv[i] = *(const u32x4*)(zr + 256); }
#pragma unroll
      for (int i = 0; i < 6; ++i) { const int id = tid + 512 * i, row = id >> 5, c8 = (id & 31) * 8, tp = tpos0 - 30 + row; const u32x4 ca = cav[i], cg = cgv[i];
          f32x4 a, b;
          a[0] = bflo(ca.x) * SG(bflo(cg.x)); a[1] = bfhi(ca.x) * SG(bfhi(cg.x)); a[2] = bflo(ca.y) * SG(bflo(cg.y)); a[3] = bfhi(ca.y) * SG(bfhi(cg.y));
          b[0] = bflo(ca.z) * SG(bflo(cg.z)); b[1] = bfhi(ca.z) * SG(bfhi(cg.z)); b[2] = bflo(ca.w) * SG(bflo(cg.w)); b[3] = bfhi(ca.w) * SG(bfhi(cg.w));
          if (tp < 0) { a = (f32x4){0.f, 0.f, 0.f, 0.f}; b = a; }
          if (id < 94 * 32) { *(LAS f32x4*)(ub + row * 256 + c8) = a; *(LAS f32x4*)(ub + row * 256 + c8 + 4) = b; } } }
#undef SG
    __syncthreads();
    { const int ch = tid & 255, half = tid >> 8; float acc[32]; const float bias = ccb[ch];
#pragma unroll
      for (int j = 0; j < 32; ++j) acc[j] = bias;
      for (int k = 0; k < 31; ++k) { const float w = ccw[k * 256 + ch]; LAS const float* up = ub + (half * 32 + k) * 256 + ch;
#pragma unroll
          for (int j = 0; j < 32; ++j) acc[j] = __builtin_fmaf(w, up[j * 256], acc[j]); }
      __syncthreads();
#pragma unroll
      for (int j = 0; j < 32; ++j) ub[(half * 32 + j) * 256 + ch] = acc[j]; }
    __syncthreads();
    { const int wid = tid >> 6, lane = tid & 63; const f32x4 gg = *(const f32x4*)(lng + lane * 4), bb = *(const f32x4*)(lnb + lane * 4);
      for (int j = 0; j < 8; ++j) { const int tok = wid * 8 + j; const f32x4 y = *(LAS const f32x4*)(ub + tok * 256 + lane * 4);
          const float mean = wave_sum(y[0] + y[1] + y[2] + y[3]) * (1.f / 256.f); const f32x4 d = y - mean;
          const float var = wave_sum(d[0] * d[0] + d[1] * d[1] + d[2] * d[2] + d[3] * d[3]) * (1.f / 256.f), rstd = rsqrtf(var + 1e-6f);
          const f32x4 z = d * rstd * gg + bb; u32x2 w; w.x = cvtpk(silu_f(z[0]), silu_f(z[1])); w.y = cvtpk(silu_f(z[2]), silu_f(z[3]));
          *(u32x2*)(MIX + (size_t)(t0 + tok) * DM + 512 + lane * 4) = w; } }
#pragma unroll 2
    for (int i = 0; i < 4; ++i) { const int id = tid + 512 * i, tok = id >> 5, c8 = (id & 31) * 8, tp = tpos0 + tok; const bf16_t* zr = Z + (size_t)(t0 + tok) * DIN + 2048 + c8;
        u32x4 gcv[3], hsv[3];
#pragma unroll
        for (int k = 0; k < 3; ++k) { int back = 2 - k; back = (t0 + tok - back < 0) ? 0 : back; const bf16_t* zk = zr - (size_t)back * DIN; gcv[k] = *(const u32x4*)(zk + 256); hsv[k] = *(const u32x4*)(zk + 512); }
        const u32x4 gb = *(const u32x4*)zr;
        float y[8];
#pragma unroll
        for (int e = 0; e < 8; ++e) y[e] = 0.f;
#pragma unroll
        for (int k = 0; k < 3; ++k) { const u32x4 gc = gcv[k], hs = hsv[k]; const float on = (tp - 2 + k >= 0) ? 1.f : 0.f;
                const f32x4 w0 = *(const f32x4*)(scw + k * 256 + c8) * on, w1 = *(const f32x4*)(scw + k * 256 + c8 + 4) * on;
                y[0] += w0[0] * bflo(gc.x) * bflo(hs.x); y[1] += w0[1] * bfhi(gc.x) * bfhi(hs.x); y[2] += w0[2] * bflo(gc.y) * bflo(hs.y); y[3] += w0[3] * bfhi(gc.y) * bfhi(hs.y);
                y[4] += w1[0] * bflo(gc.z) * bflo(hs.z); y[5] += w1[1] * bfhi(gc.z) * bfhi(hs.z); y[6] += w1[2] * bflo(gc.w) * bflo(hs.w); y[7] += w1[3] * bfhi(gc.w) * bfhi(hs.w); }
        u32x4 w;
        w.x = cvtpk(bflo(gb.x) * y[0], bfhi(gb.x) * y[1]); w.y = cvtpk(bflo(gb.y) * y[2], bfhi(gb.y) * y[3]); w.z = cvtpk(bflo(gb.z) * y[4], bfhi(gb.z) * y[5]); w.w = cvtpk(bflo(gb.w) * y[6], bfhi(gb.w) * y[7]);
        *(u32x4*)(MIX + (size_t)(t0 + tok) * DM + 768 + c8) = w; }
}
#ifndef PROBE_SYNC
#define PROBE_SYNC 0
#endif
#ifndef PROBE_MASK
#define PROBE_MASK 0
#endif

struct Params { const float* in[29]; float* out; unsigned char* ws; int ph_lo, ph_hi, fused_final, pad_; };
constexpr size_t MiB = 1u << 20;
constexpr size_t WS_W = 0, WS_CTL = 97 * MiB, CTL_BYTES = 32768, WS_XB0 = WS_CTL + 65536, WS_XB1 = WS_XB0 + 32 * MiB, WS_BIG = WS_XB1 + 32 * MiB, WS_KV = WS_BIG + 88 * MiB, WS_PS = WS_KV + 8 * MiB, WS_END2 = WS_PS + 1 * MiB;
constexpr size_t WS_MEMN = WS_XB1;
constexpr size_t WO_GU1 = 0, WO_D1 = WO_GU1 + (size_t)5632 * 1024, WO_IN = WO_D1 + (size_t)1024 * 2816, WO_OUT = WO_IN + (size_t)2816 * 1024, WO_Q = WO_OUT + (size_t)1024 * 1024,
                 WO_KV = WO_Q + (size_t)1024 * 1024, WO_O = WO_KV + (size_t)2048 * 1024, WO_GU2 = WO_O + (size_t)1024 * 1024, WO_D2 = WO_GU2 + (size_t)5632 * 1024, WO_LAYER = WO_D2 + (size_t)1024 * 2816;
static_assert(2 * WO_LAYER * 2 <= WS_CTL && WS_END2 <= 262 * MiB, "workspace map");
constexpr int N_PHASES = 20, PPL = 9;
#define XB_TMO      128
#define XB_XCNT(j)  (256  + 64 * (j))
#define XB_XSUB(j)  (1280 + 64 * (j))
#define XB_XGEN(j)  (2304 + 64 * (j))
#define XB_TOP      3328
#define XB_TOPGEN   3392
#define XCD_BAR_WORDS 3456
#define XB_SPIN_CAP (1u << 18)

__device__ __forceinline__ unsigned xb_ld(unsigned* p)              { return __hip_atomic_load(p, __ATOMIC_RELAXED, __HIP_MEMORY_SCOPE_AGENT); }
__device__ __forceinline__ unsigned xb_add(unsigned* p, unsigned v) { return __hip_atomic_fetch_add(p, v, __ATOMIC_RELAXED, __HIP_MEMORY_SCOPE_AGENT); }
__device__ __forceinline__ unsigned xb_xcc_id() { return (unsigned)__builtin_amdgcn_s_getreg((3 << 11) | 20) & 0xFu; }
#define XB_SPIN(cond, bar) do { unsigned _sp = 0; while (cond) { __builtin_amdgcn_s_sleep(1); \
    if ((++_sp & 255u) == 0u) { if (xb_ld(&(bar)[XB_TMO])) break; if (_sp > XB_SPIN_CAP) { atomicAdd(&(bar)[XB_TMO], 1u); break; } } } } while (0)

struct XcdBarrier {
    unsigned* bar; unsigned x;
    volatile LAS unsigned* st;
};

__device__ __forceinline__ XcdBarrier xcd_barrier_post(unsigned* bar, volatile LAS unsigned* st) {
    XcdBarrier b; b.bar = bar; b.x = xb_xcc_id(); b.st = st;
    if (threadIdx.x == 0) (void)xb_add(&bar[XB_XCNT(b.x)], 1u);
    return b;
}
__device__ __forceinline__ void xcd_barrier_complete(unsigned* bar, unsigned x, unsigned& nloc, unsigned& nx) {
    const unsigned G = gridDim.x * gridDim.y * gridDim.z;
    unsigned sum, cnt, mine, sp = 0u;
    for (;;) {
        sum = 0u; cnt = 0u; mine = 0u;
#pragma unroll
        for (unsigned j = 0; j < 16; ++j) { const unsigned c = xb_ld(&bar[XB_XCNT(j)]); sum += c; cnt += (c > 0u) ? 1u : 0u; mine = (j == x) ? c : mine; }
        if (sum == G) break;
        __builtin_amdgcn_s_sleep(1);
        if ((++sp & 255u) == 0u) { if (xb_ld(&bar[XB_TMO])) break; if (sp > XB_SPIN_CAP) { atomicAdd(&bar[XB_TMO], 1u); break; } }
    }
    nloc = mine > 0u ? mine : 1u; nx = cnt > 0u ? cnt : 1u;
}

__device__ __forceinline__ void xcd_barrier(const XcdBarrier& b) {
    asm volatile("s_waitcnt vmcnt(0)" ::: "memory");
    __syncthreads();
    if (threadIdx.x == 0) {
        unsigned* bar = b.bar;
        __builtin_amdgcn_s_waitcnt(0);
        unsigned nloc = b.st[0], nx = b.st[1];
        if (nloc == 0u) { xcd_barrier_complete(bar, b.x, nloc, nx); b.st[0] = nloc; b.st[1] = nx; }
        const unsigned old = xb_add(&bar[XB_XSUB(b.x)], 1u);
        const unsigned gen = old / nloc;
        if (old + 1u == (gen + 1u) * nloc) {
            __builtin_amdgcn_fence(__ATOMIC_RELEASE, "agent");
            asm volatile("s_waitcnt vmcnt(0)" ::: "memory");
            const unsigned og = xb_add(&bar[XB_TOP], 1u);
            const unsigned tg = og / nx;
            if (og + 1u == (tg + 1u) * nx) xb_add(&bar[XB_TOPGEN], 1u);
            else XB_SPIN(xb_ld(&bar[XB_TOPGEN]) == tg, bar);
            __builtin_amdgcn_fence(__ATOMIC_ACQUIRE, "agent");
            xb_add(&bar[XB_XGEN(b.x)], 1u);
            asm volatile("s_waitcnt vmcnt(0)" ::: "memory");
        } else {
            XB_SPIN(xb_ld(&bar[XB_XGEN(b.x)]) == gen, bar);
            __builtin_amdgcn_fence(__ATOMIC_ACQUIRE, "agent");
            asm volatile("s_waitcnt vmcnt(0)" ::: "memory");
        }
    }
    __syncthreads();
}


__device__ __forceinline__ void run_phase(const Params& p, LAS unsigned char* lds, int ph, bool dummy) {
    bf16_t* WB = (bf16_t*)(p.ws + WS_W); bf16_t* XB0 = (bf16_t*)(p.ws + WS_XB0); bf16_t* XB1 = (bf16_t*)(p.ws + WS_XB1); bf16_t* BIG = (bf16_t*)(p.ws + WS_BIG); bf16_t* KV = (bf16_t*)(p.ws + WS_KV); bf16_t* MEMN = (bf16_t*)(p.ws + WS_MEMN);
    float* RSA = (float*)(p.ws + WS_PS); float* RSB = RSA + MTOK;
    bf16_t* OXA = BIG + (size_t)MTOK * DM;
    float* X = p.out;
    if (ph == 0) {
        {
            bf16_t* wl = WB;
            cvt_w(lds, p.in[3], DM, DFF, wl + WO_GU1, 1, p.in[2]); cvt_w(lds, p.in[4], DM, DFF, wl + WO_GU1, 2, p.in[2]);
            cvt_w(lds, p.in[5], DFF, DM, wl + WO_D1, 0, nullptr, 0, 0, 0.5f);
            cvt_w(lds, p.in[7], DM, DIN, wl + WO_IN, 0, p.in[6]);
            cvt_w(lds, p.in[18], DM, DM, wl + WO_OUT, 0);
            cvt_w(lds, p.in[21], DM, DM, wl + WO_Q, 0, p.in[19]);
            cvt_w(lds, p.in[23], DM, DM, wl + WO_O, 0);
            cvt_w(lds, p.in[25], DM, DFF, wl + WO_GU2, 1, p.in[24]); cvt_w(lds, p.in[26], DM, DFF, wl + WO_GU2, 2, p.in[24]);
            cvt_w(lds, p.in[27], DFF, DM, wl + WO_D2, 0, nullptr, 0, 0, 0.5f);
        }
#pragma unroll 1
        for (int l = 0; l < DEPTH; ++l) {
            cvt_w(lds, p.in[22] + (size_t)l * DM * 2048, DM, 2048, WB + l * WO_LAYER + WO_KV, 0);
            norm_rows_bf16(p.in[1], p.in[20] + l * DM, MEMN + (size_t)l * MMEM * DM, MMEM);
        }
        prep_rows(p.in[0], XB0, RSA, MTOK);
        for (int i = bid_opq() * 512 + tid_opq(); i < MTOK; i += gridDim.x * 512) RSB[i] = 0.f;
        return;
    }
    if (ph == N_PHASES - 1) { final_rows(XB0, XB1, p.out, RSA, p.in[28], MTOK); return; }
    const int l = (ph - 1) / PPL, s = (ph - 1) % PPL;
    bf16_t* wl = WB + l * WO_LAYER;
    const float lam_init = l == 0 ? 0.2f : 0.35550907f;
    int kind = 0, nstore = 0; const bf16_t* A = XB0; const bf16_t* Bt = wl; int N = DM, K = DM; bf16_t* Ob = BIG; int ldc = DM; const float* Xin = X; float scale = 1.f;
    switch (s) {
    case 0: kind = 2; Bt = wl + WO_GU1; N = 5632; ldc = DFF; if (l == 0) nstore = 2; break;
    case 1: kind = 3; A = BIG; Bt = wl + WO_D1; K = DFF; Xin = (l == 0) ? p.in[0] : X; scale = 0.5f; break;
    case 2: nstore = 1; Bt = wl + WO_IN; N = DIN; ldc = DIN; break;
    case 3: {
        const int lane = tid_opq() & 63;
        float a = p.in[8][l * 64 + lane] * p.in[9][l * 64 + lane], b = p.in[10][l * 64 + lane] * p.in[11][l * 64 + lane];
        a = wave_sum(a); b = wave_sum(b);
        const float lam = __expf(a) - __expf(b) + lam_init;
        const bf16_t* Z = BIG;
#pragma unroll 1
        for (int pj = bid_opq(); pj < 256; pj += gridDim.x) { const int bh = (pj & 7) * 2 + (pj >> 7), xp = (pj >> 3) & 15, b_ = bh >> 2, h = bh & 3; const float sl2 = exp2f(-2.f * (float)(h + 1)) * LOG2E;
#pragma unroll 1
            for (int rep = 0; rep < 2; ++rep) { const int x = rep ? xp : 31 - xp; const bf16_t* zb = Z + (size_t)(b_ * SEQ) * DIN + h * 128;
                attn_unit<true>(lds, zb + (size_t)(x * 128) * DIN, DIN, zb + 512, zb + 1024, DIN, 2 * (x + 1), x * 128, 0.125f * LOG2E, sl2, lam,
                                XB1 + (size_t)(b_ * SEQ + x * 128) * DM + h * 128, DM, p.in[12] + l * 128, 1.f - lam_init); } }
#pragma unroll 1
        for (int u = bid_opq(); u < MTOK / 64; u += gridDim.x) conv_unit(lds, Z, XB1, u, p.in[13] + l * 31 * 256, p.in[14] + l * 256, p.in[15] + l * 256, p.in[16] + l * 256, p.in[17] + l * 3 * 256);
    } break;
    case 4: kind = 3; A = XB1; Bt = wl + WO_OUT; break;
    case 5: nstore = 1; Bt = wl + WO_Q; break;
    case 6: kind = 3; A = OXA; Bt = wl + WO_O; break;
    case 7: kind = 2; Bt = wl + WO_GU2; N = 5632; ldc = DFF; break;
    case 8: kind = 3; A = BIG; Bt = wl + WO_D2; K = DFF; scale = 0.5f; break;
    }
    const bool consA = (s == 0 || s == 5);
    float* rs_in = consA ? RSA : RSB; float* rs_zero = consA ? RSB : RSA; float* rs_acc = (s == 1 || s == 6) ? RSB : RSA;
    if (kind == 2 || nstore) { for (int i = bid_opq() * 512 + tid_opq(); i < MTOK; i += gridDim.x * 512) rs_zero[i] = 0.f; }
    if (kind == 2) { EpiSwiglu E; E.O = BIG; E.ldc = DFF; E.RS = rs_in; E.pad_ = 0; run_gemm(lds, A, Bt, MTOK, N, K, E); }
#pragma unroll 1
    for (int rep = 0; rep < nstore; ++rep) {
        EpiStore E; E.O = Ob; E.ldc = ldc; E.RS = rs_in; E.pad_ = 0; int M = MTOK, off = 0; const bf16_t* a2 = A; const bf16_t* b2 = Bt; int n2 = N;
        if (s == 0) { a2 = MEMN + (size_t)rep * MMEM * DM; b2 = WB + rep * WO_LAYER + WO_KV; M = MMEM; n2 = 2048; E.O = KV + (size_t)rep * MMEM * 2048; E.ldc = 2048; E.RS = nullptr; off = 128 + 32 * rep; }
        run_gemm(lds, a2, b2, M, n2, K, E, off);
    }
    if (s == 5 && !dummy) {
        asm volatile("s_waitcnt vmcnt(0)" ::: "memory"); __syncthreads();
        const bf16_t* kvl = KV + (size_t)l * MMEM * 2048;
        OffOrder S; S.init(MTOK, DM, (int)gridDim.x, bid_opq(), 0); Unit u;
#pragma unroll 1
        for (int i = 0; S.next(i, u); ++i) {
#pragma unroll 1
            for (int hh = 0; hh < 2; ++hh) { const int row = u.pm * 256 + hh * 128, b_ = row / SEQ, h = u.pn; const size_t qo = (size_t)row * DM + h * 256;
                const bf16_t* kp = kvl + (size_t)(b_ * MEML) * 2048 + h * 256;
                attn_unit<false>(lds, BIG + qo, DM, kp, kp + 1024, 2048, 4, 0, 0.0625f * LOG2E, 0.f, 0.f, OXA + qo, DM, nullptr, 1.f); } }
    }
    if (l == 0 && !dummy) { bf16_t* w1 = WB + WO_LAYER; const int bid = bid_opq();
        if (s == 0 && bid >= 192) { cvt_w(lds, p.in[5] + (size_t)DM * DFF, DFF, DM, w1 + WO_D1, 0, nullptr, 192, 64, 0.5f); cvt_w(lds, p.in[18] + (size_t)DM * DM, DM, DM, w1 + WO_OUT, 0, nullptr, 192, 64); }
        if (s == 2 && bid >= 192) { cvt_w(lds, p.in[7] + (size_t)DM * DIN, DM, DIN, w1 + WO_IN, 0, p.in[6] + DM, 192, 64); cvt_w(lds, p.in[21] + (size_t)DM * DM, DM, DM, w1 + WO_Q, 0, p.in[19] + DM, 192, 64); }
        if (s == 7 && bid >= 128) { cvt_w(lds, p.in[3] + (size_t)DM * DFF, DM, DFF, w1 + WO_GU1, 1, p.in[2] + DM, 128, 128); cvt_w(lds, p.in[4] + (size_t)DM * DFF, DM, DFF, w1 + WO_GU1, 2, p.in[2] + DM, 128, 128);
                                    cvt_w(lds, p.in[23] + (size_t)DM * DM, DM, DM, w1 + WO_O, 0, nullptr, 128, 128); cvt_w(lds, p.in[27] + (size_t)DM * DFF, DFF, DM, w1 + WO_D2, 0, nullptr, 128, 128, 0.5f); }
    }
    if (l == 1 && s == 0 && !dummy && bid_opq() >= 128) { bf16_t* w1 = WB + WO_LAYER;
        cvt_w(lds, p.in[25] + (size_t)DM * DFF, DM, DFF, w1 + WO_GU2, 1, p.in[24] + DM, 128, 128); cvt_w(lds, p.in[26] + (size_t)DM * DFF, DM, DFF, w1 + WO_GU2, 2, p.in[24] + DM, 128, 128); }
    bf16_t* LOD = (bf16_t*)p.out;
    HiLoIn hin; hin.Xin32 = (l == 0 && s == 1) ? p.in[0] : nullptr; hin.HiIn = XB0; hin.LoIn = (l == DEPTH - 1 && s == PPL - 1) ? XB1 : LOD;
    bf16_t* lo_out = (l == DEPTH - 1 && s >= 6) ? XB1 : LOD;
    if (kind == 3 && ph == N_PHASES - 2 && p.fused_final) {
        EpiFinal E; E.in = hin; E.Out = p.out; E.RS = rs_acc; E.g = p.in[28]; E.cnt = (unsigned*)(p.ws + WS_CTL) + 3584; run_gemm(lds, A, Bt, MTOK, N, K, E, 0, 1); kind = 0; }
    if (kind == 3) { EpiResid E; E.in = hin; E.HiOut = XB0; E.LoOut = lo_out; E.RS = rs_acc; run_gemm(lds, A, Bt, MTOK, N, K, E, 0, K == DFF ? 1 : 0); }
}

__global__ void __launch_bounds__(512) mega_kernel(Params p) {
    extern __shared__ __attribute__((aligned(16))) unsigned char smem[];
    LAS unsigned char* lds = (LAS unsigned char*)smem;
    volatile LAS unsigned* st = (volatile LAS unsigned*)(lds + LDS_BYTES - 64);
    if (threadIdx.x == 0) { st[0] = 0u; st[1] = 0u; }
    __syncthreads();
    const XcdBarrier xb = xcd_barrier_post((unsigned*)(p.ws + WS_CTL), st);
    cg::grid_group grid = cg::this_grid();
    if (p.ph_lo < 0) grid.sync();
#pragma unroll 1
    for (int ph = p.ph_lo; ph < p.ph_hi; ++ph) {
        if (ph > p.ph_lo) xcd_barrier(xb);
#if PROBE_SYNC
        xcd_barrier(xb);
#endif
        int dup = 0;
#if PROBE_MASK
        { const int s = (ph - 1) % PPL; const bool mid = ph > 0 && ph < N_PHASES - 1;
          if ((PROBE_MASK & 1) && mid && (s == 0 || s == 8)) dup = 1;
          if ((PROBE_MASK & 2) && mid && (s == 2 || s == 5)) dup = 1;
          if ((PROBE_MASK & 4) && mid && (s == 1 || s == 4 || s == 7 || s == 9)) dup = 1;
          if ((PROBE_MASK & 8) && mid && s == 3) dup = 1;
          if ((PROBE_MASK & 16) && mid && s == 6) dup = 1;
          if ((PROBE_MASK & 32) && ph == 0) dup = 1; }
#endif
#pragma unroll 1
        for (int rep = dup ? 0 : 1; rep < 2; ++rep) run_phase(p, lds, ph, rep == 0);
    }
}

#ifndef MK_PER_PHASE
#define MK_PER_PHASE 0
#endif
extern "C" void kernel_launch(void* const* d_in, const int* in_sizes, int n_in, void* d_out, int out_size, void* d_ws, size_t ws_size, hipStream_t stream) {
    static int grid = 0;
    if (grid == 0) {
        if (n_in != 29 || out_size != MTOK * DM || ws_size < WS_END2) { fprintf(stderr, "kernel_launch: unexpected shapes n_in %d out %d ws %zu\n", n_in, out_size, ws_size); grid = -1; return; }
        int dev = 0, cus = 0, per_cu = 0;
        hipGetDevice(&dev); hipDeviceGetAttribute(&cus, hipDeviceAttributeMultiprocessorCount, dev);
        if (hipFuncSetAttribute((const void*)mega_kernel, hipFuncAttributeMaxDynamicSharedMemorySize, LDS_BYTES) != hipSuccess) { fprintf(stderr, "kernel_launch: hipFuncSetAttribute failed\n"); grid = -1; return; }
        if (hipOccupancyMaxActiveBlocksPerMultiprocessor(&per_cu, (const void*)mega_kernel, 512, LDS_BYTES) != hipSuccess || per_cu < 1) { fprintf(stderr, "kernel_launch: occupancy query says %d\n", per_cu); per_cu = 1; }
        (void)hipGetLastError();
        grid = cus * 1;
        fprintf(stderr, "kernel_launch: cus %d per_cu %d grid %d\n", cus, per_cu, grid);
    }
    if (grid < 0) return;
    if (hipMemsetAsync((char*)d_ws + WS_CTL, 0, CTL_BYTES, stream) != hipSuccess) { fprintf(stderr, "kernel_launch: memset failed\n"); return; }
    Params p{};
    for (int i = 0; i < 29; ++i) p.in[i] = (const float*)d_in[i];
    p.out = (float*)d_out; p.ws = (unsigned char*)d_ws;
#if MK_PER_PHASE
    for (int ph = 0; ph < N_PHASES; ++ph) { p.ph_lo = ph; p.ph_hi = ph + 1; void* args[] = {&p};
        hipError_t e = hipLaunchCooperativeKernel((const void*)mega_kernel, dim3(grid), dim3(512), args, LDS_BYTES, stream);
        if (e != hipSuccess) { fprintf(stderr, "kernel_launch: launch %d failed: %s\n", ph, hipGetErrorString(e)); break; } }
#else
    p.fused_final = (grid == 256) ? 1 : 0;
    p.ph_lo = 0; p.ph_hi = p.fused_final ? N_PHASES - 1 : N_PHASES; void* args[] = {&p};
    hipError_t e = hipLaunchCooperativeKernel((const void*)mega_kernel, dim3(grid), dim3(512), args, LDS_BYTES, stream);
    if (e != hipSuccess) fprintf(stderr, "kernel_launch: cooperative launch failed: %s (grid %d)\n", hipGetErrorString(e), grid);
#endif
}
```
